# Optimizing an MI355X kernel written in HIP

```python
import math
import jax, jax.numpy as jnp
from jax import lax
import numpy as np

D_MODEL = 1024
BATCH = 4
SEQ = 4096
DEPTH = 2

PLE_DIM = 256
D_FF = 2816
N_EVEN = (DEPTH + 1) // 2
N_ODD = DEPTH // 2
DN_ALPHA = (2.0 * DEPTH) ** 0.25
DN_BETA = (8.0 * DEPTH) ** -0.25
LN_EPS = 1e-5
SSD_INNER = D_MODEL
SSD_HEAD_DIM = 64
SSD_HEADS = SSD_INNER // SSD_HEAD_DIM
SSD_GROUPS = 4
SSD_STATE = 128
SSD_CONV = 4
SSD_CHUNK = 128
SSD_CONV_DIM = SSD_INNER + 2 * SSD_GROUPS * SSD_STATE
S5_WIDTH = D_MODEL
S5_GROUP = 16
S5_GROUPS = S5_WIDTH // S5_GROUP
S5_STATE = 64
HGRN_HEADS = 4
HGRN_KEY = 128
HGRN_VAL = 128
HGRN_WIDTH = HGRN_HEADS * HGRN_VAL
GLA_HEADS = 4
GLA_DK = 64
GLA_DV = 128
GLA_RANK = 16
GLA_TAU = 16.0
GLA_WIDTH = GLA_HEADS * GLA_DV
LIN_CHUNK = 64
AB_SPLITS = (SSD_INNER, SSD_CONV_DIM, SSD_HEADS, S5_WIDTH)
AB_IN = sum(AB_SPLITS)
AB_OUT = SSD_INNER + S5_WIDTH
CD_SPLITS = (HGRN_HEADS * HGRN_KEY, HGRN_HEADS * HGRN_KEY, HGRN_WIDTH, HGRN_WIDTH,
             GLA_HEADS * GLA_DK, GLA_HEADS * GLA_DK, GLA_WIDTH, GLA_RANK, GLA_WIDTH)
CD_IN = sum(CD_SPLITS)
CD_OUT = HGRN_WIDTH + GLA_WIDTH

kernel_name = "hybrid_ssd_s5_hgrn2_gla_macaron_deepnorm"


def split_cols(h, sizes):
    return jnp.split(h, np.cumsum(sizes)[:-1].tolist(), axis=-1)


def layer_norm(x, g, b):
    xf = x.astype(jnp.float32)
    mu = jnp.mean(xf, -1, keepdims=True)
    xc = xf - mu
    var = jnp.mean(xc * xc, -1, keepdims=True)
    return (xc * lax.rsqrt(var + LN_EPS) * g + b).astype(x.dtype)


def rms_norm(x, w):
    xf = x.astype(jnp.float32)
    return (xf * lax.rsqrt(jnp.mean(xf * xf, -1, keepdims=True) + LN_EPS) * w).astype(x.dtype)


def swiglu(x, w_gate, w_up, w_down):
    return (jax.nn.silu(x @ w_gate) * (x @ w_up)) @ w_down


def causal_depthwise_conv(x, w, b):
    k = w.shape[0]
    y = lax.conv_general_dilated(x, w[:, None, :], window_strides=(1,), padding=[(k - 1, 0)],
                                 dimension_numbers=('NWC', 'WIO', 'NWC'),
                                 feature_group_count=x.shape[-1])
    return y + b


def ssd_chunked(x, dt, a, bmat, cmat):
    b, l, h, p = x.shape
    g, n = bmat.shape[2:]
    r = h // g
    nc = l // SSD_CHUNK
    xdt = (x * dt[..., None]).reshape(b, nc, SSD_CHUNK, g, r, p)
    a_cum = jnp.cumsum((dt * a).reshape(b, nc, SSD_CHUNK, g, r), axis=2)
    bc = bmat.reshape(b, nc, SSD_CHUNK, g, n)
    cc = cmat.reshape(b, nc, SSD_CHUNK, g, n)
    causal = jnp.tril(jnp.ones((SSD_CHUNK, SSD_CHUNK), bool))[None, None, :, :, None, None]
    seg = a_cum[:, :, :, None] - a_cum[:, :, None, :]
    decay = jnp.exp(jnp.where(causal, seg, -jnp.inf))
    scores = jnp.einsum('bclgn,bcsgn->bclsg', cc, bc)
    y_diag = jnp.einsum('bclsgr,bcsgrp->bclgrp', scores[..., None] * decay, xdt)
    decay_to_end = jnp.exp(a_cum[:, :, -1:] - a_cum)
    states = jnp.einsum('bclgn,bclgrp->bcgrpn', bc, xdt * decay_to_end[..., None])
    chunk_decay = jnp.exp(a_cum[:, :, -1])

    def step(hstate, inp):
        dec, st = inp
        return dec[..., None, None] * hstate + st, hstate

    h0 = jnp.zeros((b, g, r, p, n), jnp.float32)
    _, prev = lax.scan(step, h0, (jnp.moveaxis(chunk_decay, 1, 0), jnp.moveaxis(states, 1, 0)))
    prev = jnp.moveaxis(prev, 0, 1)
    y_off = jnp.einsum('bclgn,bcgrpn->bclgrp', cc, prev) * jnp.exp(a_cum)[..., None]
    return (y_diag + y_off).reshape(b, l, h, p)


def ssd_mixer(z, xbc, dt_raw, conv_w, conv_b, dt_bias, a_log, d_skip, norm_w):
    b, l, _ = z.shape
    xbc = jax.nn.silu(causal_depthwise_conv(xbc, conv_w, conv_b))
    xs, bm, cm = jnp.split(xbc, [SSD_INNER, SSD_INNER + SSD_GROUPS * SSD_STATE], axis=-1)
    xs = xs.reshape(b, l, SSD_HEADS, SSD_HEAD_DIM)
    bm = bm.reshape(b, l, SSD_GROUPS, SSD_STATE)
    cm = cm.reshape(b, l, SSD_GROUPS, SSD_STATE)
    dt = jax.nn.softplus((dt_raw + dt_bias).astype(jnp.float32))
    a = -jnp.exp(a_log.astype(jnp.float32))
    y = ssd_chunked(xs, dt, a, bm, cm) + xs * d_skip[:, None]
    y = y.reshape(b, l, SSD_INNER) * jax.nn.silu(z)
    y = rms_norm(y.reshape(b, l, SSD_GROUPS, -1), norm_w.reshape(SSD_GROUPS, -1))
    return y.reshape(b, l, SSD_INNER).astype(z.dtype)


def linear_recurrence_combine(e1, e2):
    a1, b1 = e1
    a2, b2 = e2
    return a1 * a2, a2 * b1 + b2


def s5_mixer(u, lam_re, lam_im, log_dt, b_re, b_im, c_re, c_im, d_skip, w_glu, b_glu):
    b, l, _ = u.shape
    f32 = jnp.float32
    ug = u.reshape(b, l, S5_GROUPS, S5_GROUP).astype(f32)
    lam = lax.complex(lam_re.astype(f32), lam_im.astype(f32))
    dt = jnp.exp(log_dt.astype(f32))[:, None]
    lam_bar = jnp.exp(lam * dt)
    b_bar = ((lam_bar - 1.0) / lam)[..., None] * lax.complex(b_re.astype(f32), b_im.astype(f32))
    bu = jnp.einsum('blgp,gnp->blgn', ug.astype(jnp.complex64), b_bar)
    a = jnp.broadcast_to(lam_bar, (1, l) + lam_bar.shape)
    _, states = lax.associative_scan(linear_recurrence_combine, (a, bu), axis=1)
    c = lax.complex(c_re.astype(f32), c_im.astype(f32))
    y = jnp.real(jnp.einsum('blgn,gpn->blgp', states, c)) + d_skip.astype(f32) * ug
    y = jax.nn.gelu(y.reshape(b, l, S5_WIDTH))
    y = y * jax.nn.sigmoid(y @ w_glu.astype(f32) + b_glu.astype(f32))
    return y.astype(u.dtype)


def gla_chunked(q, k, v, log_f):
    b, l, h, dk = q.shape
    dv = v.shape[-1]
    nc = l // LIN_CHUNK

    def to_chunks(t):
        return jnp.moveaxis(t.reshape(b, nc, LIN_CHUNK, *t.shape[2:]), 1, 0)

    qc, kc, vc, gc = to_chunks(q), to_chunks(k), to_chunks(v), to_chunks(log_f.astype(jnp.float32))
    causal = jnp.tril(jnp.ones((LIN_CHUNK, LIN_CHUNK), bool))[None, :, :, None, None]

    def step(s, inp):
        q_, k_, v_, g_ = inp
        gcum = jnp.cumsum(g_, axis=1)
        diff = gcum[:, :, None] - gcum[:, None, :]
        decay = jnp.exp(jnp.where(causal, diff, -jnp.inf))
        attn = jnp.einsum('blshd,bshd->bhls', decay * q_[:, :, None], k_)
        o = (jnp.einsum('bhls,bshv->blhv', attn, v_)
             + jnp.einsum('blhd,bhdv->blhv', q_ * jnp.exp(gcum), s))
        g_last = gcum[:, -1]
        s = (jnp.exp(g_last)[..., None] * s
             + jnp.einsum('bshd,bshv->bhdv', k_ * jnp.exp(g_last[:, None] - gcum), v_))
        return s, o

    s0 = jnp.zeros((b, h, dk, dv), jnp.float32)
    _, o = lax.scan(step, s0, (qc, kc, vc, gc))
    return jnp.moveaxis(o, 0, 1).reshape(b, l, h, dv).astype(v.dtype)


def hgrn_lower_bound(lb_logits, layer):
    cum = jnp.cumsum(jax.nn.softmax(lb_logits.astype(jnp.float32), axis=0), axis=0)
    return cum[layer] - cum[0]


def mixer_ab(x, w_in, w_out, conv_w, conv_b, dt_bias, a_log, d_skip, norm_w,
             lam_re, lam_im, log_dt, b_re, b_im, c_re, c_im, s5_d, w_glu, b_glu):
    z, xbc, dt_raw, u = split_cols(x @ w_in, AB_SPLITS)
    y_a = ssd_mixer(z, xbc, dt_raw, conv_w, conv_b, dt_bias, a_log, d_skip, norm_w)
    y_b = s5_mixer(u, lam_re, lam_im, log_dt, b_re, b_im, c_re, c_im, s5_d, w_glu, b_glu)
    return jnp.concatenate([y_a, y_b], axis=-1) @ w_out


def mixer_cd(x, w_in, w_out, lb, hgrn_norm_w, gla_w_gate_up, gla_b_gate, gla_norm_w):
    b, l, _ = x.shape
    hq, hf, hi, hg, gq, gk, gv, glr, gr = split_cols(x @ w_in, CD_SPLITS)
    q = jax.nn.silu(hq).reshape(b, l, HGRN_HEADS, HGRN_KEY)
    f_logit = hf.astype(jnp.float32).reshape(b, l, HGRN_HEADS, HGRN_KEY)
    lb = lb.reshape(HGRN_HEADS, HGRN_KEY)
    log_f = jnp.logaddexp(jnp.log(lb), jnp.log1p(-lb) + jax.nn.log_sigmoid(f_logit))
    k = (1.0 - lb) * jax.nn.sigmoid(-f_logit)
    v = hi.reshape(b, l, HGRN_HEADS, HGRN_VAL)
    o_c = gla_chunked(q, k, v, log_f)
    o_c = rms_norm(o_c, hgrn_norm_w.reshape(HGRN_HEADS, HGRN_VAL)).reshape(b, l, HGRN_WIDTH) * jax.nn.silu(hg)
    q = gq.reshape(b, l, GLA_HEADS, GLA_DK) * (GLA_DK ** -0.5)
    k = gk.reshape(b, l, GLA_HEADS, GLA_DK)
    v = gv.reshape(b, l, GLA_HEADS, GLA_DV)
    log_a = jax.nn.log_sigmoid((glr @ gla_w_gate_up + gla_b_gate).astype(jnp.float32)) / GLA_TAU
    o_d = gla_chunked(q, k, v, log_a.reshape(b, l, GLA_HEADS, GLA_DK))
    o_d = rms_norm(o_d, gla_norm_w.reshape(GLA_HEADS, GLA_DV)).reshape(b, l, GLA_WIDTH) * jax.nn.silu(gr)
    return jnp.concatenate([o_c.astype(x.dtype), o_d.astype(x.dtype)], axis=-1) @ w_out


def setup_inputs(seed: int = 0) -> dict:
    key = jax.random.key(seed)
    ks = iter(jax.random.split(key, 48))
    f32 = jnp.float32

    def nrm(shape, scale):
        return scale * jax.random.normal(next(ks), shape, f32)

    def unif(shape, lo, hi):
        return jax.random.uniform(next(ks), shape, f32, minval=lo, maxval=hi)

    dt0 = jnp.exp(unif((N_EVEN, SSD_HEADS), math.log(1e-3), math.log(1e-1)))
    return {
        "x": nrm((BATCH, SEQ, D_MODEL), 1.0),
        "p": nrm((DEPTH, BATCH, SEQ, PLE_DIM), 1.0),
        "ln_g": 1.0 + nrm((DEPTH, 3, D_MODEL), 0.02),
        "ln_b": nrm((DEPTH, 3, D_MODEL), 0.02),
        "ffn_w_gate": nrm((DEPTH, 2, D_MODEL, D_FF), D_MODEL ** -0.5),
        "ffn_w_up": nrm((DEPTH, 2, D_MODEL, D_FF), D_MODEL ** -0.5),
        "ffn_w_down": nrm((DEPTH, 2, D_FF, D_MODEL), DN_BETA * D_FF ** -0.5),
        "ple_w_gate": nrm((DEPTH, D_MODEL, D_MODEL), D_MODEL ** -0.5),
        "ple_w_proj": nrm((DEPTH, PLE_DIM, D_MODEL), PLE_DIM ** -0.5),
        "ab_w_in": nrm((N_EVEN, D_MODEL, AB_IN), D_MODEL ** -0.5),
        "ab_w_out": nrm((N_EVEN, AB_OUT, D_MODEL), DN_BETA * AB_OUT ** -0.5),
        "ssd_conv_w": nrm((N_EVEN, SSD_CONV, SSD_CONV_DIM), SSD_CONV ** -0.5),
        "ssd_conv_b": nrm((N_EVEN, SSD_CONV_DIM), 0.02),
        "ssd_dt_bias": dt0 + jnp.log(-jnp.expm1(-dt0)),
        "ssd_a_log": jnp.log(unif((N_EVEN, SSD_HEADS), 1.0, 16.0)),
        "ssd_d": 1.0 + nrm((N_EVEN, SSD_HEADS), 0.02),
        "ssd_norm_w": 1.0 + nrm((N_EVEN, SSD_INNER), 0.02),
        "s5_lambda_re": -0.5 + nrm((N_EVEN, S5_GROUPS, S5_STATE), 0.01),
        "s5_lambda_im": jnp.pi * jnp.arange(S5_STATE, dtype=f32) + nrm((N_EVEN, S5_GROUPS, S5_STATE), 0.01),
        "s5_log_dt": unif((N_EVEN, S5_GROUPS), math.log(1e-3), math.log(1e-1)),
        "s5_b_re": nrm((N_EVEN, S5_GROUPS, S5_STATE, S5_GROUP), (2.0 * S5_GROUP) ** -0.5),
        "s5_b_im": nrm((N_EVEN, S5_GROUPS, S5_STATE, S5_GROUP), (2.0 * S5_GROUP) ** -0.5),
        "s5_c_re": nrm((N_EVEN, S5_GROUPS, S5_GROUP, S5_STATE), S5_STATE ** -0.5),
        "s5_c_im": nrm((N_EVEN, S5_GROUPS, S5_GROUP, S5_STATE), S5_STATE ** -0.5),
        "s5_d": nrm((N_EVEN, S5_GROUPS, S5_GROUP), 1.0),
        "s5_w_glu": nrm((N_EVEN, S5_WIDTH, S5_WIDTH), S5_WIDTH ** -0.5),
        "s5_b_glu": nrm((N_EVEN, S5_WIDTH), 0.02),
        "cd_w_in": nrm((N_ODD, D_MODEL, CD_IN), D_MODEL ** -0.5),
        "cd_w_out": nrm((N_ODD, CD_OUT, D_MODEL), DN_BETA * CD_OUT ** -0.5),
        "hgrn_lb_logits": nrm((DEPTH, HGRN_HEADS * HGRN_KEY), 0.5),
        "hgrn_norm_w": 1.0 + nrm((N_ODD, HGRN_WIDTH), 0.02),
        "gla_w_gate_up": nrm((N_ODD, GLA_RANK, GLA_HEADS * GLA_DK), GLA_RANK ** -0.5),
        "gla_b_gate": nrm((N_ODD, GLA_HEADS * GLA_DK), 0.1),
        "gla_norm_w": 1.0 + nrm((N_ODD, GLA_WIDTH), 0.02),
    }


def reference(x, p, ln_g, ln_b, ffn_w_gate, ffn_w_up, ffn_w_down, ple_w_gate, ple_w_proj,
              ab_w_in, ab_w_out, ssd_conv_w, ssd_conv_b, ssd_dt_bias, ssd_a_log, ssd_d, ssd_norm_w,
              s5_lambda_re, s5_lambda_im, s5_log_dt, s5_b_re, s5_b_im, s5_c_re, s5_c_im, s5_d,
              s5_w_glu, s5_b_glu, cd_w_in, cd_w_out, hgrn_lb_logits, hgrn_norm_w,
              gla_w_gate_up, gla_b_gate, gla_norm_w):
    for i in range(DEPTH):
        j = i // 2
        x = layer_norm(DN_ALPHA * x + 0.5 * swiglu(x, ffn_w_gate[i, 0], ffn_w_up[i, 0], ffn_w_down[i, 0]),
                       ln_g[i, 0], ln_b[i, 0])
        if i % 2 == 0:
            mix = mixer_ab(x, ab_w_in[j], ab_w_out[j], ssd_conv_w[j], ssd_conv_b[j], ssd_dt_bias[j],
                           ssd_a_log[j], ssd_d[j], ssd_norm_w[j], s5_lambda_re[j], s5_lambda_im[j],
                           s5_log_dt[j], s5_b_re[j], s5_b_im[j], s5_c_re[j], s5_c_im[j], s5_d[j],
                           s5_w_glu[j], s5_b_glu[j])
        else:
            mix = mixer_cd(x, cd_w_in[j], cd_w_out[j], hgrn_lower_bound(hgrn_lb_logits, i),
                           hgrn_norm_w[j], gla_w_gate_up[j], gla_b_gate[j], gla_norm_w[j])
        x = layer_norm(DN_ALPHA * x + mix, ln_g[i, 1], ln_b[i, 1])
        x = layer_norm(DN_ALPHA * x + 0.5 * swiglu(x, ffn_w_gate[i, 1], ffn_w_up[i, 1], ffn_w_down[i, 1]),
                       ln_g[i, 2], ln_b[i, 2])
        x = x + jax.nn.sigmoid(x @ ple_w_gate[i]) * (p[i] @ ple_w_proj[i])
    return x
```

```cpp
#include <hip/hip_runtime.h>
#include <hip/hip_cooperative_groups.h>
#include <cstdio>
namespace cg = cooperative_groups;
namespace pg8 {
#define PG8_LAS __attribute__((address_space(3)))
typedef unsigned short bf16_t;
typedef short bf16x8 __attribute__((ext_vector_type(8)));
typedef float f32x4 __attribute__((ext_vector_type(4)));
typedef unsigned u32x4 __attribute__((ext_vector_type(4)));
constexpr int BM = 256, BK = 64, HALF = 128, HTB = HALF * BK * 2  , STAGE_BYTES = 8 * HTB, NXCD = 8, WGM = 8;

__host__ __device__ __forceinline__ int lds_byte(int r, int c) { const int st = (r >> 4) * 2 + (c >> 5), rr = r & 15, cc = c & 31, ob = rr * 64 + cc * 2; return st * 1024 + (ob ^ (((ob >> 9) & 1) << 5)); }
__host__ __device__ __forceinline__ void stage_rc(int b, int& R, int& C) { const int st = b / 1024, sb = b % 1024, swz = sb ^ (((sb >> 9) & 1) << 5); R = (st >> 1) * 16 + swz / 64; C = (st & 1) * 32 + (swz % 64) / 2; }
__host__ __device__ __forceinline__ int perm32(int rho) { const int n = rho >> 4, i = rho & 15; return 8 * (i >> 2) + 4 * n + (i & 3); }

struct Unit { int pm, pn; };
struct Gemm { const bf16_t* A; const bf16_t* Bt; int M, N, K, lda; };

struct StaticOrder {
    int nM, nN, nwg, G, c;
    __host__ __device__ void init(int M, int N, int G_, int c_) { nM = M / BM; nN = N / BM; nwg = nM * nN; G = G_; c = c_; }
    __host__ __device__ bool next(int i, Unit& u) const {
        const long L = (long)i * G + c; if (L >= nwg) return false;
        int wgid = (int)L; { const int q = nwg / NXCD, r = nwg % NXCD, xcd = wgid % NXCD, off = wgid / NXCD; wgid = (xcd < r ? xcd * (q + 1) : r * (q + 1) + (xcd - r) * q) + off; }
        const int nig = WGM * nN, gid = wgid / nig, fm = gid * WGM, gsz = (nM - fm) < WGM ? (nM - fm) : WGM;
        u.pm = fm + ((wgid % nig) % gsz); u.pn = (wgid % nig) / gsz; return true;
    }
    __device__ __forceinline__ void a_ready(const Unit&) const {}
    __device__ __forceinline__ void done(const Unit&) const {}
};
__device__ __forceinline__ unsigned cvt_pk_bf16(float lo, float hi) { unsigned r; asm volatile("v_cvt_pk_bf16_f32 %0, %1, %2" : "=v"(r) : "v"(lo), "v"(hi)); return r; }
template <class Epi, class Sched, bool STAMP = false>
__device__ __forceinline__ void gemm_phase(PG8_LAS unsigned char* lds, const Gemm g, const Sched& S, const Epi& E, unsigned long long* stamps) {
    int tid_o = threadIdx.x; asm volatile("" : "+v"(tid_o)); const int tid = tid_o, wid = __builtin_amdgcn_readfirstlane(tid >> 6), lane = tid & 63, wr = wid >> 2, wc = wid & 3, fr = lane & 15, fq = lane >> 4;
    const int K = g.K, nt = K / BK;
    int ts_lo = 0, ts_hi = 0, nts = 0; const unsigned long long rt_entry = STAMP ? (unsigned long long)wall_clock64() : 0ull;
#define PG8_STAMP() do { if (STAMP && wid == 0 && nts < 64) { const unsigned long long _c = (unsigned long long)clock64(); \
        ts_lo = (lane == nts) ? (int)(unsigned)_c : ts_lo; ts_hi = (lane == nts) ? (int)(unsigned)(_c >> 32) : ts_hi; ++nts; } } while (0)
    PG8_STAMP();
    unsigned voffA[2], voffB[2];
#pragma unroll
    for (int i = 0; i < 2; ++i) { int R, C; stage_rc(tid * 16 + i * 8192, R, C); const int Rb = Epi::PERM ? ((R & ~31) + perm32(R & 31)) : R;
        voffA[i] = (unsigned)(R * g.lda + C) * 2u; voffB[i] = (unsigned)(Rb * K + C) * 2u; }
    const size_t kstep = (size_t)(BK * 2);
    const size_t hstepB = (size_t)HALF * K * 2, hstepA = (size_t)HALF * g.lda * 2;
    const size_t tstepA = 2 * hstepA, tstepB = 2 * hstepB;
    const unsigned ldsw = (unsigned)wid * 1024u;
    const int aoff = lds_byte(wr * 64 + fr, fq * 8), boff = lds_byte(wc * 32 + fr, fq * 8);
#define PG8_SA(b, h) (((b) * 2 + (h)) * HTB)
#define PG8_SB(b, h) ((4 + (b) * 2 + (h)) * HTB)
#define PG8_STAGE(bufoff, gbase, voff) do { _Pragma("unroll") for (int _i = 0; _i < 2; ++_i) \
        __builtin_amdgcn_global_load_lds((const unsigned*)((const char*)(gbase) + (voff)[_i]), (PG8_LAS unsigned*)(lds + (bufoff) + ldsw + _i * 8192), 16, 0, 0); } while (0)
#define PG8_LDA(dst, b, h) do { _Pragma("unroll") for (int m = 0; m < 4; ++m) _Pragma("unroll") for (int k = 0; k < 2; ++k) dst[m][k] = *(const PG8_LAS bf16x8*)(lds + PG8_SA(b, h) + aoff + m * 2048 + k * 1024); } while (0)
#define PG8_LDB(dst, b, h) do { _Pragma("unroll") for (int n = 0; n < 2; ++n) _Pragma("unroll") for (int k = 0; k < 2; ++k) dst[n][k] = *(const PG8_LAS bf16x8*)(lds + PG8_SB(b, h) + boff + n * 2048 + k * 1024); } while (0)
#define PG8_MMA(ai, bj, At, Bt) do { __builtin_amdgcn_s_setprio(1); _Pragma("unroll") for (int m = 0; m < 4; ++m) _Pragma("unroll") for (int n = 0; n < 2; ++n) _Pragma("unroll") for (int k = 0; k < 2; ++k) \
        acc[ai][bj][m][n] = __builtin_amdgcn_mfma_f32_16x16x32_bf16(Bt[n][k], At[m][k], acc[ai][bj][m][n], 0, 0, 0); __builtin_amdgcn_s_setprio(0); } while (0)
#define PG8_WAIT_V(n) asm volatile("s_waitcnt vmcnt(" #n ")" ::: "memory")
#define PG8_WAIT_L(n) asm volatile("s_waitcnt lgkmcnt(" #n ")" ::: "memory")
#define PG8_BAR __builtin_amdgcn_s_barrier()
#define PG8_SCHED __builtin_amdgcn_sched_barrier(0)
    Unit cur, nxt; int ui = 0;
    if (!S.next(0, cur)) return;
    f32x4 acc[2][2][4][2];
#pragma unroll
    for (int a = 0; a < 2; ++a)
#pragma unroll
        for (int b = 0; b < 2; ++b)
#pragma unroll
            for (int m = 0; m < 4; ++m)
#pragma unroll
                for (int n = 0; n < 2; ++n) acc[a][b][m][n] = (f32x4){0.f, 0.f, 0.f, 0.f};
    bf16x8 At[4][2], B0[2][2], B1[2][2];
    const char* cA = (const char*)g.A + (size_t)cur.pm * tstepA; const char* cB = (const char*)g.Bt + (size_t)cur.pn * tstepB;
    S.a_ready(cur);
    PG8_STAGE(PG8_SB(0, 0), cB, voffB); PG8_STAGE(PG8_SA(0, 0), cA, voffA); PG8_STAGE(PG8_SB(0, 1), cB + hstepB, voffB); PG8_STAGE(PG8_SA(0, 1), cA + hstepA, voffA);
    if (wr == 1) PG8_BAR;
    PG8_WAIT_V(4); PG8_BAR;
    PG8_STAGE(PG8_SB(1, 0), cB + kstep, voffB); PG8_STAGE(PG8_SA(1, 0), cA + kstep, voffA); PG8_STAGE(PG8_SB(1, 1), cB + hstepB + kstep, voffB);
    PG8_WAIT_V(6); PG8_BAR;
    PG8_STAMP();
    for (;;) {
        const bool has_next = S.next(ui + 1, nxt);
        const char* nA = has_next ? (const char*)g.A + (size_t)nxt.pm * tstepA : cA; const char* nB = has_next ? (const char*)g.Bt + (size_t)nxt.pn * tstepB : cB;
        for (int t = 0; t < nt; t += 2) {
            const bool last = (t == nt - 2);
            const char* a1 = cA + (size_t)(t + 1) * kstep;
            const char* a2 = last ? nA : cA + (size_t)(t + 2) * kstep; const char* b2 = last ? nB : cB + (size_t)(t + 2) * kstep;
            const char* a3 = a2 + kstep; const char* b3 = b2 + kstep;
            if (last && has_next) S.a_ready(nxt);
            PG8_LDB(B0, 0, 0); PG8_SCHED; PG8_LDA(At, 0, 0); PG8_STAGE(PG8_SA(1, 1), a1 + hstepA, voffA);
            PG8_WAIT_L(8); PG8_BAR; PG8_WAIT_L(0); PG8_MMA(0, 0, At, B0); PG8_BAR; PG8_SCHED;
            PG8_LDB(B1, 0, 1); PG8_STAGE(PG8_SB(0, 0), b2, voffB);
            PG8_BAR; PG8_WAIT_L(0); PG8_MMA(0, 1, At, B1); PG8_BAR;
            PG8_LDA(At, 0, 1); PG8_STAGE(PG8_SA(0, 0), a2, voffA);
            PG8_BAR; PG8_WAIT_L(0); PG8_MMA(1, 0, At, B0); PG8_BAR; PG8_SCHED;
            PG8_STAGE(PG8_SB(0, 1), b2 + hstepB, voffB);
            PG8_WAIT_V(6); PG8_BAR; PG8_MMA(1, 1, At, B1); PG8_BAR;
            PG8_LDB(B0, 1, 0); PG8_SCHED; PG8_LDA(At, 1, 0); PG8_STAGE(PG8_SA(0, 1), a2 + hstepA, voffA);
            PG8_WAIT_L(8); PG8_BAR; PG8_WAIT_L(0); PG8_MMA(0, 0, At, B0); PG8_BAR; PG8_SCHED;
            PG8_LDB(B1, 1, 1); PG8_STAGE(PG8_SB(1, 0), b3, voffB);
            PG8_BAR; PG8_WAIT_L(0); PG8_MMA(0, 1, At, B1); PG8_BAR;
            PG8_LDA(At, 1, 1); PG8_STAGE(PG8_SA(1, 0), a3, voffA);
            PG8_BAR; PG8_WAIT_L(0); PG8_MMA(1, 0, At, B0); PG8_BAR; PG8_SCHED;
            PG8_STAGE(PG8_SB(1, 1), b3 + hstepB, voffB);
            PG8_WAIT_V(6); PG8_BAR; PG8_MMA(1, 1, At, B1); PG8_BAR;
        }
        PG8_STAMP();
        if constexpr (!Epi::AFTER_DRAIN) { E(acc, cur, wr, wc, fr, fq); S.done(cur); }
        PG8_STAMP();
        if (!has_next) break;
#pragma unroll
        for (int a = 0; a < 2; ++a)
#pragma unroll
            for (int b = 0; b < 2; ++b)
#pragma unroll
                for (int m = 0; m < 4; ++m)
#pragma unroll
                    for (int n = 0; n < 2; ++n) acc[a][b][m][n] = (f32x4){0.f, 0.f, 0.f, 0.f};
        cur = nxt; cA = nA; cB = nB; ++ui;
    }
    PG8_WAIT_V(0);
    if (wr == 0) PG8_BAR;
    PG8_BAR;
    if constexpr (Epi::AFTER_DRAIN) { E.fused(acc, cur, wr, wc, fr, fq, lds, wid, lane); S.done(cur); }
    PG8_STAMP();
    if (STAMP && wid == 0) { stamps[lane] = lane < nts ? (((unsigned long long)(unsigned)ts_hi << 32) | (unsigned)ts_lo) : 0ull;
        if (lane == 62) stamps[62] = rt_entry; if (lane == 63) stamps[63] = (unsigned long long)wall_clock64(); }
#undef PG8_STAMP
#undef PG8_SA
#undef PG8_SB
#undef PG8_STAGE
#undef PG8_LDA
#undef PG8_LDB
#undef PG8_MMA
#undef PG8_WAIT_V
#undef PG8_WAIT_L
#undef PG8_BAR
#undef PG8_SCHED
}
}
#define LAS __attribute__((address_space(3)))
#define DI __device__ __forceinline__
using pg8::bf16_t; using pg8::bf16x8; using pg8::f32x4; using pg8::u32x4;
typedef unsigned u32x2 __attribute__((ext_vector_type(2)));

constexpr int T_ = 16384, D_ = 1024, FF_ = 2816, L_ = 4096;
constexpr int ABW = 4352, CDW = 3840;
constexpr float DN_ALPHA = 1.41421356237f, EPS_ = 1e-5f;
constexpr int LDS_BYTES = 144 * 1024;

constexpr size_t SZ_WGU = (size_t)5632 * 1024 * 2, SZ_WD = (size_t)1024 * 2816 * 2, SZ_W1K = (size_t)1024 * 1024 * 2, SZ_WPP = (size_t)1024 * 256 * 2;
constexpr size_t OFF_WGU = 0;
constexpr size_t OFF_WD = OFF_WGU + 4 * SZ_WGU;
constexpr size_t OFF_WPG = OFF_WD + 4 * SZ_WD;
constexpr size_t OFF_WPP = OFF_WPG + 2 * SZ_W1K;
constexpr size_t OFF_WABIN = OFF_WPP + 2 * SZ_WPP;
constexpr size_t OFF_WABOUT = OFF_WABIN + (size_t)ABW * 1024 * 2;
constexpr size_t OFF_WGLU = OFF_WABOUT + (size_t)1024 * 2048 * 2;
constexpr size_t OFF_WCDIN = OFF_WGLU + SZ_W1K;
constexpr size_t OFF_WCDOUT = OFF_WCDIN + (size_t)CDW * 1024 * 2;
constexpr size_t OFF_XB = OFF_WCDOUT + SZ_W1K;
constexpr size_t OFF_BIG = OFF_XB + (size_t)T_ * 1024 * 2;
constexpr size_t SZ_BIG = (size_t)T_ * ABW * 2;
constexpr size_t OFF_PB = OFF_BIG + (size_t)T_ * FF_ * 2;
constexpr size_t OFF_S5L = OFF_BIG + SZ_BIG;
constexpr size_t OFF_S5B = OFF_S5L + 64 * 64 * 2 * 4;
constexpr size_t WS_END = OFF_S5B + (size_t)64 * 128 * 16 * 4;

DI int otid() { int t = threadIdx.x; asm volatile("" : "+v"(t)); return t; }
struct Params { const float* in[34]; float* out; unsigned char* ws; };

DI unsigned pk2(float lo, float hi) { unsigned r; asm("v_cvt_pk_bf16_f32 %0, %1, %2" : "=v"(r) : "v"(lo), "v"(hi)); return r; }
DI float bflo(unsigned w) { return __uint_as_float(w << 16); }
DI float bfhi(unsigned w) { return __uint_as_float(w & 0xffff0000u); }
DI float bf2f(bf16_t b) { return __uint_as_float(((unsigned)b) << 16); }
DI bf16_t f2bf(float f) { return (bf16_t)(pk2(f, 0.f) & 0xffffu); }
DI float sigm(float x) { return 1.f / (1.f + __expf(-x)); }
DI float silu(float x) { return x / (1.f + __expf(-x)); }
DI float softplus(float x) { return x > 20.f ? x : log1pf(__expf(x)); }
DI float logsigm(float x) { return fminf(x, 0.f) - log1pf(__expf(-fabsf(x))); }
DI float gelu_t(float x) { const float u = 0.7978845608f * (x + 0.044715f * x * x * x); return x / (1.f + __expf(-2.f * u)); }

typedef const f32x4 (&AccT)[2][2][4][2];
struct EpiSwiGLU { static constexpr bool PERM = false, AFTER_DRAIN = false; bf16_t* H;
    DI void operator()(AccT acc, const pg8::Unit& u, int wr, int wc, int fr, int fq) const {
        const int row0 = u.pm * 256 + wr * 64 + fr, col0 = u.pn * 128 + wc * 32 + 4 * fq;
#pragma unroll
        for (int ai = 0; ai < 2; ++ai)
#pragma unroll
            for (int m = 0; m < 4; ++m) { bf16_t* rowp = H + (size_t)(row0 + ai * 128 + m * 16) * FF_ + col0;
#pragma unroll
                for (int n = 0; n < 2; ++n) { const f32x4 g = acc[ai][0][m][n], v = acc[ai][1][m][n]; u32x2 w;
                    w.x = pk2(silu(g[0]) * v[0], silu(g[1]) * v[1]); w.y = pk2(silu(g[2]) * v[2], silu(g[3]) * v[3]); *(u32x2*)(rowp + n * 16) = w; } }
    } };
struct EpiRes { static constexpr bool PERM = false, AFTER_DRAIN = false; const float* base; float* out; float scale;
    DI void operator()(AccT acc, const pg8::Unit& u, int wr, int wc, int fr, int fq) const {
        const int row0 = u.pm * 256 + wr * 64 + fr, col0 = u.pn * 256 + wc * 32 + 4 * fq;
#pragma unroll
        for (int ai = 0; ai < 2; ++ai)
#pragma unroll
            for (int m = 0; m < 4; ++m) { const size_t off = (size_t)(row0 + ai * 128 + m * 16) * D_ + col0;
#pragma unroll
                for (int bj = 0; bj < 2; ++bj)
#pragma unroll
                    for (int n = 0; n < 2; ++n) { const size_t o = off + bj * 128 + n * 16; const f32x4 b = *(const f32x4*)(base + o); *(f32x4*)(out + o) = b * DN_ALPHA + acc[ai][bj][m][n] * scale; } }
    } };
struct EpiBf16 { static constexpr bool PERM = false, AFTER_DRAIN = false; bf16_t* O; int ldc;
    DI void operator()(AccT acc, const pg8::Unit& u, int wr, int wc, int fr, int fq) const {
        const int row0 = u.pm * 256 + wr * 64 + fr, col0 = u.pn * 256 + wc * 32 + 4 * fq;
#pragma unroll
        for (int ai = 0; ai < 2; ++ai)
#pragma unroll
            for (int m = 0; m < 4; ++m) { bf16_t* rowp = O + (size_t)(row0 + ai * 128 + m * 16) * ldc + col0;
#pragma unroll
                for (int bj = 0; bj < 2; ++bj)
#pragma unroll
                    for (int n = 0; n < 2; ++n) { const f32x4 v = acc[ai][bj][m][n]; u32x2 w; w.x = pk2(v[0], v[1]); w.y = pk2(v[2], v[3]); *(u32x2*)(rowp + bj * 128 + n * 16) = w; } }
    } };
struct EpiGLU { static constexpr bool PERM = false, AFTER_DRAIN = false; const bf16_t* G; bf16_t* Y; const float* bias;
    DI void operator()(AccT acc, const pg8::Unit& u, int wr, int wc, int fr, int fq) const {
        const int row0 = u.pm * 256 + wr * 64 + fr, col0 = u.pn * 256 + wc * 32 + 4 * fq;
#pragma unroll
        for (int ai = 0; ai < 2; ++ai)
#pragma unroll
            for (int m = 0; m < 4; ++m) { const size_t off = (size_t)(row0 + ai * 128 + m * 16) * ABW + col0;
#pragma unroll
                for (int bj = 0; bj < 2; ++bj)
#pragma unroll
                    for (int n = 0; n < 2; ++n) { const int cc = bj * 128 + n * 16; const f32x4 v = acc[ai][bj][m][n]; const f32x4 bv = *(const f32x4*)(bias + col0 + cc);
                        const u32x2 g = *(const u32x2*)(G + off + cc); u32x2 w;
                        w.x = pk2(bflo(g.x) * sigm(v[0] + bv[0]), bfhi(g.x) * sigm(v[1] + bv[1])); w.y = pk2(bflo(g.y) * sigm(v[2] + bv[2]), bfhi(g.y) * sigm(v[3] + bv[3]));
                        *(u32x2*)(Y + off + cc) = w; } }
    } };
struct EpiF32 { static constexpr bool PERM = false, AFTER_DRAIN = false; float* C;
    DI void operator()(AccT acc, const pg8::Unit& u, int wr, int wc, int fr, int fq) const {
        const int row0 = u.pm * 256 + wr * 64 + fr, col0 = u.pn * 256 + wc * 32 + 4 * fq;
#pragma unroll
        for (int ai = 0; ai < 2; ++ai)
#pragma unroll
            for (int m = 0; m < 4; ++m) { const size_t off = (size_t)(row0 + ai * 128 + m * 16) * D_ + col0;
#pragma unroll
                for (int bj = 0; bj < 2; ++bj)
#pragma unroll
                    for (int n = 0; n < 2; ++n) *(f32x4*)(C + off + bj * 128 + n * 16) = acc[ai][bj][m][n]; }
    } };
struct EpiPLE { static constexpr bool PERM = false, AFTER_DRAIN = false; float* X; const float* PP; bf16_t* XB;
    DI void operator()(AccT acc, const pg8::Unit& u, int wr, int wc, int fr, int fq) const {
        const int row0 = u.pm * 256 + wr * 64 + fr, col0 = u.pn * 256 + wc * 32 + 4 * fq;
#pragma unroll
        for (int ai = 0; ai < 2; ++ai)
#pragma unroll
            for (int m = 0; m < 4; ++m) { const size_t off = (size_t)(row0 + ai * 128 + m * 16) * D_ + col0;
#pragma unroll
                for (int bj = 0; bj < 2; ++bj)
#pragma unroll
                    for (int n = 0; n < 2; ++n) { const size_t o = off + bj * 128 + n * 16; const f32x4 a = acc[ai][bj][m][n]; const f32x4 x = *(const f32x4*)(X + o), pp = *(const f32x4*)(PP + o); f32x4 r;
#pragma unroll
                        for (int j = 0; j < 4; ++j) r[j] = x[j] + sigm(a[j]) * pp[j];
                        *(f32x4*)(X + o) = r; u32x2 w; w.x = pk2(r[0], r[1]); w.y = pk2(r[2], r[3]); *(u32x2*)(XB + o) = w; } }
    } };

template <class Epi> DI void run_gemm(LAS unsigned char* lds, const bf16_t* A, int lda, const bf16_t* Bt, int N, int K, const Epi& E) {
    pg8::Gemm g{A, Bt, T_, N, K, lda}; pg8::StaticOrder S; S.init(T_, N, (int)gridDim.x, (int)blockIdx.x);
    pg8::gemm_phase<Epi, pg8::StaticOrder, false>(lds, g, S, E, nullptr);
}
struct Job { const float* src; bf16_t* dst; int K, N, map; };
DI int mapn(int map, int n) {
    if (map == 0) return n;
    if (map == 1) return 256 * (n >> 7) + (n & 127);
    if (map == 2) return 256 * (n >> 7) + 128 + (n & 127);
    if (map == 3) return n < 3072 ? n : (n < 3088 ? n + 1024 : n - 16);
    return n < 1536 ? n + 1024 : (n < 2048 ? n - 1536 : (n < 3088 ? n + 512 : n - 2576));
}
DI Job get_job(const Params& P, int j) {
    unsigned char* ws = P.ws; Job J;
    if (j < 4)       { J.src = P.in[4] + (size_t)j * 1024 * 2816;        J.dst = (bf16_t*)(ws + OFF_WGU + j * SZ_WGU);        J.K = 1024; J.N = 2816; J.map = 1; }
    else if (j < 8)  { J.src = P.in[5] + (size_t)(j - 4) * 1024 * 2816;  J.dst = (bf16_t*)(ws + OFF_WGU + (j - 4) * SZ_WGU);  J.K = 1024; J.N = 2816; J.map = 2; }
    else if (j < 12) { J.src = P.in[6] + (size_t)(j - 8) * 2816 * 1024;  J.dst = (bf16_t*)(ws + OFF_WD + (j - 8) * SZ_WD);    J.K = 2816; J.N = 1024; J.map = 0; }
    else if (j < 14) { J.src = P.in[7] + (size_t)(j - 12) * 1024 * 1024; J.dst = (bf16_t*)(ws + OFF_WPG + (j - 12) * SZ_W1K); J.K = 1024; J.N = 1024; J.map = 0; }
    else if (j < 16) { J.src = P.in[8] + (size_t)(j - 14) * 256 * 1024;  J.dst = (bf16_t*)(ws + OFF_WPP + (j - 14) * SZ_WPP); J.K = 256;  J.N = 1024; J.map = 0; }
    else if (j == 16) { J.src = P.in[9];  J.dst = (bf16_t*)(ws + OFF_WABIN);  J.K = 1024; J.N = 4112; J.map = 3; }
    else if (j == 17) { J.src = P.in[10]; J.dst = (bf16_t*)(ws + OFF_WABOUT); J.K = 2048; J.N = 1024; J.map = 0; }
    else if (j == 18) { J.src = P.in[25]; J.dst = (bf16_t*)(ws + OFF_WGLU);   J.K = 1024; J.N = 1024; J.map = 0; }
    else if (j == 19) { J.src = P.in[27]; J.dst = (bf16_t*)(ws + OFF_WCDIN);  J.K = 1024; J.N = 3600; J.map = 4; }
    else              { J.src = P.in[28]; J.dst = (bf16_t*)(ws + OFF_WCDOUT); J.K = 1024; J.N = 1024; J.map = 0; }
    return J;
}
DI void convT_tile(LAS bf16_t* tl, const Job& J, int tile) {
    const int ntn = (J.N + 63) >> 6, tk = tile / ntn, tn = tile - tk * ntn, k0 = tk * 64, n0 = tn * 64, tid = otid();
    const int n4 = (tid & 15) * 4, kr = tid >> 4;
    if (n0 + n4 < J.N) {
#pragma unroll
        for (int ps = 0; ps < 2; ++ps) { const int k = kr + 32 * ps; const f32x4 v = *(const f32x4*)(J.src + (size_t)(k0 + k) * J.N + n0 + n4);
#pragma unroll
            for (int i = 0; i < 4; ++i) tl[(n4 + i) * 72 + k] = f2bf(v[i]); }
    }
    __syncthreads();
    const int n = tid >> 3, kg = tid & 7;
    if (n0 + n < J.N) { const u32x4 w = *(const LAS u32x4*)(tl + n * 72 + kg * 8); *(u32x4*)(J.dst + (size_t)mapn(J.map, n0 + n) * J.K + k0 + kg * 8) = w; }
    __syncthreads();
}
DI void sincos_d(double x, double& s, double& c) {
    const double kq = rint(x * 0.63661977236758134308); const double r = x - kq * 1.57079632679489661923; const double r2 = r * r;
    const double sr = r * (1.0 - r2 / 6.0 * (1.0 - r2 / 20.0 * (1.0 - r2 / 42.0 * (1.0 - r2 / 72.0 * (1.0 - r2 / 110.0 * (1.0 - r2 / 156.0 * (1.0 - r2 / 210.0)))))));
    const double cr = 1.0 - r2 / 2.0 * (1.0 - r2 / 12.0 * (1.0 - r2 / 30.0 * (1.0 - r2 / 56.0 * (1.0 - r2 / 90.0 * (1.0 - r2 / 132.0 * (1.0 - r2 / 182.0 * (1.0 - r2 / 240.0)))))));
    const int qd = ((int)kq) & 3;
    s = qd == 0 ? sr : (qd == 1 ? cr : (qd == 2 ? -sr : -cr)); c = qd == 0 ? cr : (qd == 1 ? -sr : (qd == 2 ? -cr : sr));
}
DI double exp_d(double x) { const double y = x * 0.015625; double e = 1.0 + y * (1.0 + y / 2.0 * (1.0 + y / 3.0 * (1.0 + y / 4.0 * (1.0 + y / 5.0 * (1.0 + y / 6.0 * (1.0 + y / 7.0 * (1.0 + y / 8.0 * (1.0 + y / 9.0 * (1.0 + y / 10.0))))))))); e *= e; e *= e; e *= e; e *= e; e *= e; e *= e; return e; }
DI void p0_phase(const Params& P, LAS unsigned char* lds) {
    const int tid = otid(), G = gridDim.x, bid = blockIdx.x;
    {
        int base = 0;
        for (int j = 0; j < 21; ++j) { const Job J = get_job(P, j); const int nt = (J.K >> 6) * ((J.N + 63) >> 6);
            int first = (bid - base % G + G) % G;
            for (int t = first; t < nt; t += G) convT_tile((LAS bf16_t*)lds, J, t);
            base += nt; }
    }
    const size_t gt = (size_t)bid * 512 + tid, gs = (size_t)G * 512;
    { u32x4 z = {0u, 0u, 0u, 0u}; u32x4* a = (u32x4*)(P.ws + OFF_WABIN + (size_t)4112 * 1024 * 2); for (size_t i = gt; i < (size_t)240 * 1024 * 2 / 16; i += gs) a[i] = z;
      u32x4* c = (u32x4*)(P.ws + OFF_WCDIN + (size_t)3600 * 1024 * 2); for (size_t i = gt; i < (size_t)240 * 1024 * 2 / 16; i += gs) c[i] = z; }
    { const f32x4* x = (const f32x4*)P.in[0]; u32x2* xb = (u32x2*)(P.ws + OFF_XB); for (size_t i = gt; i < (size_t)T_ * D_ / 4; i += gs) { const f32x4 v = x[i]; u32x2 w; w.x = pk2(v[0], v[1]); w.y = pk2(v[2], v[3]); xb[i] = w; } }
    for (size_t i = gt; i < 64 * 64; i += gs) { const int g = (int)(i >> 6), n = (int)(i & 63);
        const double dt = exp_d((double)P.in[19][g]);
        const double lr = (double)P.in[17][i], li = (double)P.in[18][i];
        const double e = exp_d(lr * dt); double sn, cs; sincos_d(li * dt, sn, cs); const double lbr = e * cs, lbi = e * sn;
        const double den = lr * lr + li * li, cr = ((lbr - 1.0) * lr + lbi * li) / den, ci = (lbi * lr - (lbr - 1.0) * li) / den;
        float* lt = (float*)(P.ws + OFF_S5L); lt[i * 2] = (float)lbr; lt[i * 2 + 1] = (float)lbi;
        float* bt = (float*)(P.ws + OFF_S5B) + (size_t)g * 128 * 16;
        for (int q = 0; q < 16; ++q) { const double br = (double)P.in[20][i * 16 + q], bi = (double)P.in[21][i * 16 + q]; bt[n * 16 + q] = (float)(cr * br - ci * bi); bt[(64 + n) * 16 + q] = (float)(cr * bi + ci * br); } }
}
DI float wave_sum(float v) { v += __shfl_xor(v, 32); v += __shfl_xor(v, 16); v += __shfl_xor(v, 8); v += __shfl_xor(v, 4); v += __shfl_xor(v, 2); v += __shfl_xor(v, 1); return v; }
DI void ln_phase(float* X, bf16_t* XB, const float* g, const float* b) {
    const int wave = otid() >> 6, lane = otid() & 63;
    for (int row = blockIdx.x * 8 + wave; row < T_; row += gridDim.x * 8) {
        float* r = X + (size_t)row * D_; f32x4 v[4]; float s = 0.f;
#pragma unroll
        for (int i = 0; i < 4; ++i) { v[i] = *(const f32x4*)(r + i * 256 + lane * 4); s += (v[i][0] + v[i][1]) + (v[i][2] + v[i][3]); }
        const float mean = wave_sum(s) * (1.f / 1024.f); float q = 0.f;
#pragma unroll
        for (int i = 0; i < 4; ++i) { v[i] = v[i] - mean; q += (v[i][0] * v[i][0] + v[i][1] * v[i][1]) + (v[i][2] * v[i][2] + v[i][3] * v[i][3]); }
        const float rstd = 1.0f / sqrtf(wave_sum(q) * (1.f / 1024.f) + EPS_);
#pragma unroll
        for (int i = 0; i < 4; ++i) { const f32x4 gg = *(const f32x4*)(g + i * 256 + lane * 4), bb = *(const f32x4*)(b + i * 256 + lane * 4); const f32x4 o = v[i] * rstd * gg + bb;
            *(f32x4*)(r + i * 256 + lane * 4) = o; u32x2 w; w.x = pk2(o[0], o[1]); w.y = pk2(o[2], o[3]); *(u32x2*)(XB + (size_t)row * D_ + i * 256 + lane * 4) = w; }
    }
}
DI void p_to_bf16(const float* p, bf16_t* pb) {
    const size_t gt = (size_t)blockIdx.x * 512 + otid(), gs = (size_t)gridDim.x * 512;
    for (size_t i = gt; i < (size_t)T_ * 256 / 4; i += gs) { const f32x4 v = ((const f32x4*)p)[i]; u32x2 w; w.x = pk2(v[0], v[1]); w.y = pk2(v[2], v[3]); ((u32x2*)pb)[i] = w; }
}
DI void ssd_rms_phase(bf16_t* BIG, const float* nw) {
    const int wave = otid() >> 6, lane = otid() & 63;
    for (int row = blockIdx.x * 8 + wave; row < T_; row += gridDim.x * 8) {
        bf16_t* r = BIG + (size_t)row * ABW + lane * 16; const u32x4 a = *(const u32x4*)r, c = *(const u32x4*)(r + 8);
        float v[16]; v[0] = bflo(a.x); v[1] = bfhi(a.x); v[2] = bflo(a.y); v[3] = bfhi(a.y); v[4] = bflo(a.z); v[5] = bfhi(a.z); v[6] = bflo(a.w); v[7] = bfhi(a.w);
        v[8] = bflo(c.x); v[9] = bfhi(c.x); v[10] = bflo(c.y); v[11] = bfhi(c.y); v[12] = bflo(c.z); v[13] = bfhi(c.z); v[14] = bflo(c.w); v[15] = bfhi(c.w);
        float s = 0.f;
#pragma unroll
        for (int i = 0; i < 16; ++i) s += v[i] * v[i];
        s += __shfl_xor(s, 8); s += __shfl_xor(s, 4); s += __shfl_xor(s, 2); s += __shfl_xor(s, 1);
        const float rstd = 1.0f / sqrtf(s * (1.f / 256.f) + EPS_);
        const float* w = nw + lane * 16; u32x4 o0, o1;
        o0.x = pk2(v[0] * rstd * w[0], v[1] * rstd * w[1]); o0.y = pk2(v[2] * rstd * w[2], v[3] * rstd * w[3]); o0.z = pk2(v[4] * rstd * w[4], v[5] * rstd * w[5]); o0.w = pk2(v[6] * rstd * w[6], v[7] * rstd * w[7]);
        o1.x = pk2(v[8] * rstd * w[8], v[9] * rstd * w[9]); o1.y = pk2(v[10] * rstd * w[10], v[11] * rstd * w[11]); o1.z = pk2(v[12] * rstd * w[12], v[13] * rstd * w[13]); o1.w = pk2(v[14] * rstd * w[14], v[15] * rstd * w[15]);
        *(u32x4*)r = o0; *(u32x4*)(r + 8) = o1;
    }
}
template <int KIND> struct Cfg;
template <> struct Cfg<0> { static constexpr int DK = 128, DV = 64, LD = ABW; };
template <> struct Cfg<1> { static constexpr int DK = 128, DV = 128, LD = CDW; };
template <> struct Cfg<2> { static constexpr int DK = 64, DV = 128, LD = CDW; };
#define MFMA16(a, b, c) __builtin_amdgcn_mfma_f32_16x16x32_bf16((a), (b), (c), 0, 0, 0)
#define FRAG(off, row, pitch) (*(const LAS bf16x8*)(lds + (off) + (row) * (pitch) + kb0))
#define ST16(off, val) (*(LAS bf16_t*)(lds + (off)) = (val))

template <int KIND>
DI void cla_item(const Params& P, LAS unsigned char* lds, const int b, const int h) {
    constexpr int DK = Cfg<KIND>::DK, DV = Cfg<KIND>::DV, LD = Cfg<KIND>::LD;
    constexpr int PQB = (DK + 8) * 2, P64B = 144;
    constexpr int oQs = 0, oKs = oQs + 64 * PQB, oKh = oKs + 64 * PQB, oVt = oKh + DK * P64B, oST = oVt + DV * P64B, oAt = oST + DV * PQB, oXs = oAt + 64 * P64B,
                  oTot = oXs + 64 * P64B, oEgm = oTot + 8 * 128 * 4, oEgl = oEgm + 512, oAc = oEgl + 512, oRed = oAc + 256;
    static_assert(oRed + 512 <= LDS_BYTES, "cla LDS");
    constexpr int NDT = DK / 16, WPD = 8 / NDT, NVT = DV / 16, NT = NVT / WPD, NVW = DV / 32, KS = DK / 32;
    const int tid = otid(), lane = tid & 63, w = __builtin_amdgcn_readfirstlane(tid >> 6), r16 = lane & 15, q4 = lane >> 4;
    const int lt = w >> 1, wh = w & 1, dti = w / WPD, vt0 = (w % WPD) * NT;
    bf16_t* BIG = (bf16_t*)(P.ws + OFF_BIG) + (size_t)b * L_ * LD;
    LAS float* tot = (LAS float*)(lds + oTot); LAS float* egm = (LAS float*)(lds + oEgm); LAS float* egl = (LAS float*)(lds + oEgl);
    LAS float* acum = (LAS float*)(lds + oAc); LAS float* red = (LAS float*)(lds + oRed);
    f32x4 accS[NT];
#pragma unroll
    for (int i = 0; i < NT; ++i) accS[i] = (f32x4){0.f, 0.f, 0.f, 0.f};
    float c_lb = 0.f, c_bg = 0.f, c_Ah = 0.f, c_dtb = 0.f, c_Dh = 0.f; float wup[16];
#pragma unroll
    for (int r = 0; r < 16; ++r) wup[r] = 0.f;
    if constexpr (KIND == 0) { c_Ah = -__expf(P.in[14][h]); c_dtb = P.in[13][h]; c_Dh = P.in[15][h]; }
    if constexpr (KIND == 1) { const int d = tid & 127; c_lb = sigm(P.in[29][512 + h * 128 + d] - P.in[29][h * 128 + d]); }
    if constexpr (KIND == 2) { const int d = tid & 63; c_bg = P.in[32][h * 64 + d];
#pragma unroll
        for (int r = 0; r < 16; ++r) wup[r] = P.in[31][r * 256 + h * 64 + d]; }

    for (int c = 0; c < 64; ++c) {
        const int t0 = c * 64;
        float eglS = 1.f;
        if constexpr (KIND == 0) {
            const int g = h >> 2; const float* cw = P.in[11]; const float* cb = P.in[12];
            const int ch = tid & 127, tg = tid >> 7, ts = t0 + tg * 16;
            float breg[16];
#pragma unroll
            for (int which = 0; which < 2; ++which) {
                const int col = (which ? 2560 : 2048) + g * 128 + ch, cc = (which ? 1536 : 1024) + g * 128 + ch;
                const float w0 = cw[cc], w1 = cw[2048 + cc], w2 = cw[4096 + cc], w3 = cw[6144 + cc], bb = cb[cc];
                const bf16_t* src = BIG + (size_t)ts * LD + col;
                float x0 = 0.f, x1 = 0.f, x2 = 0.f;
                if (ts > 0) { x0 = bf2f(src[-3 * LD]); x1 = bf2f(src[-2 * LD]); x2 = bf2f(src[-LD]); }
#pragma unroll
                for (int i = 0; i < 16; ++i) { const float x3 = bf2f(src[i * LD]); const float v = silu(w0 * x0 + w1 * x1 + w2 * x2 + w3 * x3 + bb); x0 = x1; x1 = x2; x2 = x3;
                    if (which) ST16(oQs + (tg * 16 + i) * PQB + ch * 2, f2bf(v)); else { ST16(oKs + (tg * 16 + i) * PQB + ch * 2, f2bf(v)); breg[i] = v; } }
            }
            {
                const int p = tid & 63, tg2 = tid >> 6, ts2 = t0 + tg2 * 8, cc = h * 64 + p;
                const float w0 = cw[cc], w1 = cw[2048 + cc], w2 = cw[4096 + cc], w3 = cw[6144 + cc], bb = cb[cc];
                const bf16_t* src = BIG + (size_t)ts2 * LD + 1024 + cc; const bf16_t* dsrc = BIG + (size_t)ts2 * LD + 4096 + h;
                float x0 = 0.f, x1 = 0.f, x2 = 0.f;
                if (ts2 > 0) { x0 = bf2f(src[-3 * LD]); x1 = bf2f(src[-2 * LD]); x2 = bf2f(src[-LD]); }
#pragma unroll
                for (int i = 0; i < 8; ++i) { const float x3 = bf2f(src[i * LD]); const float v = silu(w0 * x0 + w1 * x1 + w2 * x2 + w3 * x3 + bb); x0 = x1; x1 = x2; x2 = x3;
                    const float dtv = softplus(bf2f(dsrc[i * LD]) + c_dtb);
                    ST16(oVt + p * P64B + (tg2 * 8 + i) * 2, f2bf(v * dtv)); ST16(oXs + (tg2 * 8 + i) * P64B + p * 2, f2bf(v)); }
            }
            if (w == 0) { float a = softplus(bf2f(BIG[(size_t)(t0 + lane) * LD + 4096 + h]) + c_dtb) * c_Ah;
#pragma unroll
                for (int o = 1; o < 64; o <<= 1) { const float t = __shfl_up(a, o); if (lane >= o) a += t; }
                acum[lane] = a; }
            __syncthreads();
            const float alast = acum[63]; eglS = __expf(alast);
#pragma unroll
            for (int i = 0; i < 16; ++i) ST16(oKh + ch * P64B + (tg * 16 + i) * 2, f2bf(breg[i] * __expf(alast - acum[tg * 16 + i])));
            __syncthreads();
        }
        if constexpr (KIND == 1) {
            const int d = tid & 127, tg = tid >> 7, ts = t0 + tg * 16;
            float qv[16], kv[16], cv[16]; float cum = 0.f;
            const bf16_t* src = BIG + (size_t)ts * LD + h * 128 + d;
#pragma unroll
            for (int i = 0; i < 16; ++i) { const float qr = bf2f(src[i * LD + 1024]), fl = bf2f(src[i * LD + 1536]); const bf16_t vr = src[i * LD + 2048];
                const float kk = (1.f - c_lb) * sigm(-fl); cum += __logf(1.f - kk); qv[i] = silu(qr); kv[i] = kk; cv[i] = cum; ST16(oVt + d * P64B + (tg * 16 + i) * 2, vr); }
            tot[tg * 128 + d] = cum;
            __syncthreads();
            const float t0v = tot[d], t1v = tot[128 + d], t2v = tot[256 + d], t3v = tot[384 + d];
            const float off = (tg > 0 ? t0v : 0.f) + (tg > 1 ? t1v : 0.f) + (tg > 2 ? t2v : 0.f), gm = t0v + t1v, gl = gm + t2v + t3v;
#pragma unroll
            for (int i = 0; i < 16; ++i) { const float g = off + cv[i]; const int tl = tg * 16 + i;
                ST16(oQs + tl * PQB + d * 2, f2bf(qv[i] * __expf(g - gm))); ST16(oKs + tl * PQB + d * 2, f2bf(kv[i] * __expf(gm - g))); ST16(oKh + d * P64B + tl * 2, f2bf(kv[i] * __expf(gl - g))); }
            if (tg == 0) { egm[d] = __expf(gm); egl[d] = __expf(gl); }
            __syncthreads();
        }
        if constexpr (KIND == 2) {
            const int d = tid & 63, tg = tid >> 6, ts = t0 + tg * 8;
            float qv[8], kv[8], cv[8]; float cum = 0.f;
            const bf16_t* src = BIG + (size_t)ts * LD;
#pragma unroll
            for (int i = 0; i < 8; ++i) { const bf16_t* row = src + i * LD; const float qr = bf2f(row[2560 + h * 64 + d]) * 0.125f, kr = bf2f(row[2816 + h * 64 + d]);
                const u32x4 ga = *(const u32x4*)(row + 3584), gb = *(const u32x4*)(row + 3592);
                float lg = c_bg;
                lg += bflo(ga.x) * wup[0] + bfhi(ga.x) * wup[1] + bflo(ga.y) * wup[2] + bfhi(ga.y) * wup[3] + bflo(ga.z) * wup[4] + bfhi(ga.z) * wup[5] + bflo(ga.w) * wup[6] + bfhi(ga.w) * wup[7];
                lg += bflo(gb.x) * wup[8] + bfhi(gb.x) * wup[9] + bflo(gb.y) * wup[10] + bfhi(gb.y) * wup[11] + bflo(gb.z) * wup[12] + bfhi(gb.z) * wup[13] + bflo(gb.w) * wup[14] + bfhi(gb.w) * wup[15];
                cum += logsigm(lg) * 0.0625f; qv[i] = qr; kv[i] = kr; cv[i] = cum; }
            tot[tg * 128 + d] = cum;
            { const int v = tid & 127, tgv = tid >> 7; const bf16_t* vs = BIG + (size_t)(t0 + tgv * 16) * LD + 3072 + h * 128 + v;
#pragma unroll
                for (int i = 0; i < 16; ++i) ST16(oVt + v * P64B + (tgv * 16 + i) * 2, vs[i * LD]); }
            __syncthreads();
            float off = 0.f, gm = 0.f, gl = 0.f;
#pragma unroll
            for (int g2 = 0; g2 < 8; ++g2) { const float tv = tot[g2 * 128 + d]; if (g2 < tg) off += tv; if (g2 < 4) gm += tv; gl += tv; }
#pragma unroll
            for (int i = 0; i < 8; ++i) { const float g = off + cv[i]; const int tl = tg * 8 + i;
                ST16(oQs + tl * PQB + d * 2, f2bf(qv[i] * __expf(g - gm))); ST16(oKs + tl * PQB + d * 2, f2bf(kv[i] * __expf(gm - g))); ST16(oKh + d * P64B + tl * 2, f2bf(kv[i] * __expf(gl - g))); }
            if (tg == 0) { egm[d] = __expf(gm); egl[d] = __expf(gl); }
            __syncthreads();
        }
#pragma unroll
        for (int i = 0; i < NT; ++i) { const int v = 16 * (vt0 + i) + r16, d0 = 16 * dti + 4 * q4; f32x4 s = accS[i];
            if constexpr (KIND != 0) { const f32x4 e = *(const LAS f32x4*)(egm + d0); s = s * e; }
            u32x2 wv; wv.x = pk2(s[0], s[1]); wv.y = pk2(s[2], s[3]); *(LAS u32x2*)(lds + oST + v * PQB + d0 * 2) = wv; }
#pragma unroll
        for (int e = 0; e < 2; ++e) { const int st = 2 * wh + e; f32x4 a = {0.f, 0.f, 0.f, 0.f};
            if (st <= lt) {
#pragma unroll
                for (int ks = 0; ks < KS; ++ks) { const int kb0 = ks * 64 + q4 * 16; a = MFMA16(FRAG(oKs, 16 * st + r16, PQB), FRAG(oQs, 16 * lt + r16, PQB), a); }
                const int l = 16 * lt + r16, s0 = 16 * st + 4 * q4;
#pragma unroll
                for (int j = 0; j < 4; ++j) { float dec = 1.f; if constexpr (KIND == 0) dec = __expf(fminf(acum[l] - acum[s0 + j], 0.f)); a[j] = (s0 + j <= l) ? a[j] * dec : 0.f; }
            }
            u32x2 wv; wv.x = pk2(a[0], a[1]); wv.y = pk2(a[2], a[3]); *(LAS u32x2*)(lds + oAt + (16 * lt + r16) * P64B + (16 * st + 4 * q4) * 2) = wv; }
        __syncthreads();
        f32x4 accO[NVW];
        {
            bf16x8 qf[KS];
#pragma unroll
            for (int ks = 0; ks < KS; ++ks) { const int kb0 = ks * 64 + q4 * 16; qf[ks] = FRAG(oQs, 16 * lt + r16, PQB); }
#pragma unroll
            for (int i = 0; i < NVW; ++i) { const int vt = wh * NVW + i; f32x4 a = {0.f, 0.f, 0.f, 0.f};
#pragma unroll
                for (int ks = 0; ks < KS; ++ks) { const int kb0 = ks * 64 + q4 * 16; a = MFMA16(FRAG(oST, 16 * vt + r16, PQB), qf[ks], a); }
                if constexpr (KIND == 0) a = a * __expf(acum[16 * lt + r16]);
                accO[i] = a; }
#pragma unroll
            for (int ks = 0; ks < 2; ++ks) { if (ks * 32 <= 16 * lt + 15) { const int kb0 = ks * 64 + q4 * 16; const bf16x8 af = FRAG(oAt, 16 * lt + r16, P64B);
#pragma unroll
                for (int i = 0; i < NVW; ++i) accO[i] = MFMA16(FRAG(oVt, 16 * (wh * NVW + i) + r16, P64B), af, accO[i]); } }
        }
        const int lrow = 16 * lt + r16;
        if constexpr (KIND == 0) {
#pragma unroll
            for (int i = 0; i < NVW; ++i) { const int p0 = 16 * (wh * NVW + i) + 4 * q4; bf16_t* zp = BIG + (size_t)(t0 + lrow) * LD + h * 64 + p0;
                const u32x2 z = *(const u32x2*)zp; const u32x2 xs = *(const LAS u32x2*)(lds + oXs + lrow * P64B + p0 * 2); const f32x4 a = accO[i]; u32x2 wv;
                wv.x = pk2((a[0] + c_Dh * bflo(xs.x)) * silu(bflo(z.x)), (a[1] + c_Dh * bfhi(xs.x)) * silu(bfhi(z.x)));
                wv.y = pk2((a[2] + c_Dh * bflo(xs.y)) * silu(bflo(z.y)), (a[3] + c_Dh * bfhi(xs.y)) * silu(bfhi(z.y))); *(u32x2*)zp = wv; }
        } else {
            float ss = 0.f;
#pragma unroll
            for (int i = 0; i < NVW; ++i) ss += (accO[i][0] * accO[i][0] + accO[i][1] * accO[i][1]) + (accO[i][2] * accO[i][2] + accO[i][3] * accO[i][3]);
            ss += __shfl_xor(ss, 16); ss += __shfl_xor(ss, 32);
            if (q4 == 0) red[lrow * 2 + wh] = ss;
        }
#pragma unroll
        for (int i = 0; i < NT; ++i) { const int d0 = 16 * dti + 4 * q4; f32x4 s = accS[i];
            if constexpr (KIND == 0) s = s * eglS; else { const f32x4 e = *(const LAS f32x4*)(egl + d0); s = s * e; }
#pragma unroll
            for (int ks = 0; ks < 2; ++ks) { const int kb0 = ks * 64 + q4 * 16; s = MFMA16(FRAG(oKh, 16 * dti + r16, P64B), FRAG(oVt, 16 * (vt0 + i) + r16, P64B), s); }
            accS[i] = s; }
        __syncthreads();
        if constexpr (KIND != 0) {
            const float rstd = 1.0f / sqrtf((red[lrow * 2] + red[lrow * 2 + 1]) * (1.f / 128.f) + EPS_);
            const float* nw = (KIND == 1 ? P.in[30] : P.in[33]) + h * 128; const int gofs = (KIND == 1 ? 0 : 512) + h * 128;
#pragma unroll
            for (int i = 0; i < NVW; ++i) { const int v0 = 16 * (wh * NVW + i) + 4 * q4; bf16_t* gp = BIG + (size_t)(t0 + lrow) * LD + gofs + v0;
                const u32x2 gt = *(const u32x2*)gp; const f32x4 nv = *(const f32x4*)(nw + v0); const f32x4 a = accO[i] * rstd * nv; u32x2 wv;
                wv.x = pk2(a[0] * silu(bflo(gt.x)), a[1] * silu(bfhi(gt.x))); wv.y = pk2(a[2] * silu(bflo(gt.y)), a[3] * silu(bfhi(gt.y))); *(u32x2*)gp = wv; }
        }
    }
}
DI void s5_wave(const Params& P, LAS unsigned char* wl  , const int b, const int g) {
    const int lane = otid() & 63, r16 = lane & 15, q4 = lane >> 4;
    LAS float* bu = (LAS float*)wl;
    LAS bf16_t* hb = (LAS bf16_t*)(wl + 16 * 132 * 4);
    const float* ltab = (const float*)(P.ws + OFF_S5L) + (size_t)(g * 64 + lane) * 2; const float lbr = ltab[0], lbi = ltab[1];
    const float* btab = (const float*)(P.ws + OFF_S5B) + (size_t)g * 128 * 16;
    bf16x8 bfr[8];
#pragma unroll
    for (int j = 0; j < 8; ++j) { u32x4 wv = {0u, 0u, 0u, 0u};
        if (q4 < 2) { const float* s = btab + (16 * j + r16) * 16 + 8 * q4; wv.x = pk2(s[0], s[1]); wv.y = pk2(s[2], s[3]); wv.z = pk2(s[4], s[5]); wv.w = pk2(s[6], s[7]); }
        bfr[j] = __builtin_bit_cast(bf16x8, wv); }
    bf16x8 cfr[4];
#pragma unroll
    for (int ks = 0; ks < 4; ++ks) { const int n0 = 32 * ks + 8 * q4; float v[8];
#pragma unroll
        for (int i = 0; i < 8; ++i) { const int n = n0 + i; v[i] = n < 64 ? P.in[22][(size_t)(g * 16 + r16) * 64 + n] : -P.in[23][(size_t)(g * 16 + r16) * 64 + n - 64]; }
        u32x4 wv; wv.x = pk2(v[0], v[1]); wv.y = pk2(v[2], v[3]); wv.z = pk2(v[4], v[5]); wv.w = pk2(v[6], v[7]); cfr[ks] = __builtin_bit_cast(bf16x8, wv); }
    float dsk[4];
#pragma unroll
    for (int j = 0; j < 4; ++j) dsk[j] = P.in[24][g * 16 + 4 * q4 + j];
    bf16_t* U = (bf16_t*)(P.ws + OFF_BIG) + (size_t)b * L_ * ABW + 3072 + g * 16;
    float hr = 0.f, hi = 0.f;
    u32x4 an[4]; u32x2 un[4];
#pragma unroll
    for (int s = 0; s < 4; ++s) { an[s] = (u32x4){0u, 0u, 0u, 0u}; if (q4 < 2) an[s] = *(const u32x4*)(U + (size_t)(s * 16 + r16) * ABW + 8 * q4); un[s] = *(const u32x2*)(U + (size_t)(s * 16 + r16) * ABW + 4 * q4); }
    for (int c = 0; c < 64; ++c) {
        u32x4 ac[4]; u32x2 uc[4];
#pragma unroll
        for (int s = 0; s < 4; ++s) { ac[s] = an[s]; uc[s] = un[s]; }
        if (c < 63) {
#pragma unroll
            for (int s = 0; s < 4; ++s) { const bf16_t* up = U + (size_t)((c + 1) * 64 + s * 16 + r16) * ABW; if (q4 < 2) an[s] = *(const u32x4*)(up + 8 * q4); un[s] = *(const u32x2*)(up + 4 * q4); }
        }
#pragma unroll
        for (int s = 0; s < 4; ++s) {
            const bf16x8 af = __builtin_bit_cast(bf16x8, ac[s]);
#pragma unroll
            for (int j = 0; j < 8; ++j) { f32x4 a = {0.f, 0.f, 0.f, 0.f}; a = MFMA16(af, bfr[j], a);
#pragma unroll
                for (int jj = 0; jj < 4; ++jj) bu[(4 * q4 + jj) * 132 + 16 * j + r16] = a[jj]; }
            __builtin_amdgcn_fence(__ATOMIC_RELEASE, "wavefront"); __builtin_amdgcn_wave_barrier(); __builtin_amdgcn_fence(__ATOMIC_ACQUIRE, "wavefront");
#pragma unroll
            for (int t = 0; t < 16; ++t) { const float re = bu[t * 132 + lane], im = bu[t * 132 + 64 + lane];
                const float nr = lbr * hr - lbi * hi + re, ni = lbr * hi + lbi * hr + im; hr = nr; hi = ni;
                hb[t * 136 + lane] = f2bf(hr); hb[t * 136 + 64 + lane] = f2bf(hi); }
            __builtin_amdgcn_fence(__ATOMIC_RELEASE, "wavefront"); __builtin_amdgcn_wave_barrier(); __builtin_amdgcn_fence(__ATOMIC_ACQUIRE, "wavefront");
            f32x4 y = {0.f, 0.f, 0.f, 0.f};
#pragma unroll
            for (int ks = 0; ks < 4; ++ks) { const bf16x8 hf = *(const LAS bf16x8*)(hb + r16 * 136 + 32 * ks + 8 * q4); y = MFMA16(cfr[ks], hf, y); }
            const float u0 = bflo(uc[s].x), u1 = bfhi(uc[s].x), u2 = bflo(uc[s].y), u3 = bfhi(uc[s].y); u32x2 wv;
            wv.x = pk2(gelu_t(y[0] + dsk[0] * u0), gelu_t(y[1] + dsk[1] * u1)); wv.y = pk2(gelu_t(y[2] + dsk[2] * u2), gelu_t(y[3] + dsk[3] * u3));
            *(u32x2*)(U + (size_t)(c * 64 + s * 16 + r16) * ABW + 4 * q4) = wv;
            __builtin_amdgcn_wave_barrier();
        }
    }
}
constexpr size_t OFF_XB2 = OFF_PB + (size_t)T_ * 256 * 2;
static_assert(OFF_XB2 + (size_t)T_ * 1024 * 2 <= OFF_BIG + SZ_BIG, "BIG tail");
__global__ void __launch_bounds__(512, 2) mega(Params P) {
    extern __shared__ __attribute__((aligned(16))) unsigned char shm[];
    LAS unsigned char* lds = (LAS unsigned char*)shm;
    cg::grid_group grid = cg::this_grid();
    unsigned char* ws = P.ws;
    bf16_t* XB = (bf16_t*)(ws + OFF_XB); bf16_t* XB2 = (bf16_t*)(ws + OFF_XB2); bf16_t* BIG = (bf16_t*)(ws + OFF_BIG); bf16_t* PB = (bf16_t*)(ws + OFF_PB); float* PP = (float*)(ws + OFF_BIG); float* X = P.out;
    const int wave = __builtin_amdgcn_readfirstlane(otid() >> 6);
#ifndef NO_P0
    p0_phase(P, lds);
#endif
    grid.sync();
#pragma unroll 1
    for (int l = 0; l < 2; ++l) {
        const float* lng = P.in[2] + (size_t)l * 3 * D_; const float* lnb = P.in[3] + (size_t)l * 3 * D_;
        run_gemm(lds, l == 0 ? XB : XB2, D_, (const bf16_t*)(ws + OFF_WGU + (size_t)(l * 2) * SZ_WGU), 5632, D_, EpiSwiGLU{BIG}); grid.sync();
        run_gemm(lds, BIG, FF_, (const bf16_t*)(ws + OFF_WD + (size_t)(l * 2) * SZ_WD), D_, FF_, EpiRes{l == 0 ? P.in[0] : X, X, 0.5f}); grid.sync();
        ln_phase(X, XB, lng, lnb); grid.sync();
        if (l == 0) {
            run_gemm(lds, XB, D_, (const bf16_t*)(ws + OFF_WABIN), ABW, D_, EpiBf16{BIG, ABW}); grid.sync();
            for (int it = blockIdx.x; it < 96; it += gridDim.x) {
#ifndef NO_CLA0
                if (it < 64) cla_item<0>(P, lds, it >> 4, it & 15);
                else
#endif
                { const int idx = (it - 64) * 8 + wave;
#ifndef NO_S5
 s5_wave(P, lds + wave * 13312, idx >> 6, idx & 63);
#endif
 }
                __syncthreads();
            }
            grid.sync();
            run_gemm(lds, BIG + 3072, ABW, (const bf16_t*)(ws + OFF_WGLU), D_, D_, EpiGLU{BIG + 3072, BIG + 1024, P.in[26]});
            ssd_rms_phase(BIG, P.in[16]); grid.sync();
            run_gemm(lds, BIG, ABW, (const bf16_t*)(ws + OFF_WABOUT), D_, 2048, EpiRes{X, X, 1.0f}); grid.sync();
        } else {
            run_gemm(lds, XB, D_, (const bf16_t*)(ws + OFF_WCDIN), CDW, D_, EpiBf16{BIG, CDW}); grid.sync();
            for (int it = blockIdx.x; it < 32; it += gridDim.x) {
#ifndef NO_CLA1
                if (it < 16) cla_item<1>(P, lds, it >> 2, it & 3);
#endif
#ifndef NO_CLA2
                if (it >= 16) cla_item<2>(P, lds, (it - 16) >> 2, it & 3);
#endif
                __syncthreads();
            }
            grid.sync();
            run_gemm(lds, BIG, CDW, (const bf16_t*)(ws + OFF_WCDOUT), D_, D_, EpiRes{X, X, 1.0f}); grid.sync();
        }
        ln_phase(X, XB, lng + D_, lnb + D_); grid.sync();
        run_gemm(lds, XB, D_, (const bf16_t*)(ws + OFF_WGU + (size_t)(l * 2 + 1) * SZ_WGU), 5632, D_, EpiSwiGLU{BIG}); grid.sync();
        run_gemm(lds, BIG, FF_, (const bf16_t*)(ws + OFF_WD + (size_t)(l * 2 + 1) * SZ_WD), D_, FF_, EpiRes{X, X, 0.5f}); grid.sync();
        ln_phase(X, XB, lng + 2 * D_, lnb + 2 * D_); p_to_bf16(P.in[1] + (size_t)l * T_ * 256, PB); grid.sync();
        run_gemm(lds, PB, 256, (const bf16_t*)(ws + OFF_WPP + (size_t)l * SZ_WPP), D_, 256, EpiF32{PP});
        run_gemm(lds, XB, D_, (const bf16_t*)(ws + OFF_WPG + (size_t)l * SZ_W1K), D_, D_, EpiPLE{X, PP, XB2});
        if (l == 0) grid.sync();
    }
}

extern "C" void kernel_launch(void* const* d_in, const int* in_sizes, int n_in, void* d_out, int out_size, void* d_ws, size_t ws_size, hipStream_t stream) {
    static int grid = 0;
    if (grid == 0) {
        if (n_in != 34 || out_size != T_ * D_ || ws_size < WS_END) { fprintf(stderr, "kernel_launch: unexpected shapes (n_in %d, out %d, ws %zu < %zu)\n", n_in, out_size, ws_size, (size_t)WS_END); grid = -1; return; }
        int dev = 0, cus = 0, per_cu = 0;
        hipGetDevice(&dev); hipDeviceGetAttribute(&cus, hipDeviceAttributeMultiprocessorCount, dev);
        if (hipFuncSetAttribute((const void*)mega, hipFuncAttributeMaxDynamicSharedMemorySize, LDS_BYTES) != hipSuccess) { fprintf(stderr, "kernel_launch: hipFuncSetAttribute failed\n"); grid = -1; return; }
        if (hipOccupancyMaxActiveBlocksPerMultiprocessor(&per_cu, (const void*)mega, 512, LDS_BYTES) != hipSuccess || per_cu < 1) { fprintf(stderr, "kernel_launch: occupancy query says %d\n", per_cu); per_cu = 1; }
        (void)hipGetLastError();
        grid = cus * per_cu;
    }
    if (grid < 0) return;
    Params P{};
    for (int i = 0; i < 34; ++i) P.in[i] = (const float*)d_in[i];
    P.out = (float*)d_out; P.ws = (unsigned char*)d_ws;
    void* args[] = {&P};
    hipError_t e = hipLaunchCooperativeKernel((const void*)mega, dim3(grid), dim3(512), args, LDS_BYTES, stream);
    if (e != hipSuccess) fprintf(stderr, "cooperative launch failed: %s (grid %d)\n", hipGetErrorString(e), grid);
}
```

```cpp
#include <hip/hip_runtime.h>
#include <hip/hip_cooperative_groups.h>
#include <cstdio>
namespace cg = cooperative_groups;
namespace pg8 {
#define PG8_LAS __attribute__((address_space(3)))
typedef unsigned short bf16_t;
typedef short bf16x8 __attribute__((ext_vector_type(8)));
typedef float f32x4 __attribute__((ext_vector_type(4)));
typedef unsigned u32x4 __attribute__((ext_vector_type(4)));
constexpr int BM = 256, BK = 64, HALF = 128, HTB = HALF * BK * 2  , STAGE_BYTES = 8 * HTB, NXCD = 8, WGM = 8;

__host__ __device__ __forceinline__ int lds_byte(int r, int c) { const int st = (r >> 4) * 2 + (c >> 5), rr = r & 15, cc = c & 31, ob = rr * 64 + cc * 2; return st * 1024 + (ob ^ (((ob >> 9) & 1) << 5)); }
__host__ __device__ __forceinline__ void stage_rc(int b, int& R, int& C) { const int st = b / 1024, sb = b % 1024, swz = sb ^ (((sb >> 9) & 1) << 5); R = (st >> 1) * 16 + swz / 64; C = (st & 1) * 32 + (swz % 64) / 2; }
__host__ __device__ __forceinline__ int perm32(int rho) { const int n = rho >> 4, i = rho & 15; return 8 * (i >> 2) + 4 * n + (i & 3); }

struct Unit { int pm, pn; };
struct Gemm { const bf16_t* A; const bf16_t* Bt; int M, N, K, lda; };

struct StaticOrder {
    int nM, nN, nwg, G, c;
    __host__ __device__ void init(int M, int N, int G_, int c_) { nM = M / BM; nN = N / BM; nwg = nM * nN; G = G_; c = c_; }
    __host__ __device__ bool next(int i, Unit& u) const {
        const long L = (long)i * G + c; if (L >= nwg) return false;
        int wgid = (int)L; { const int q = nwg / NXCD, r = nwg % NXCD, xcd = wgid % NXCD, off = wgid / NXCD; wgid = (xcd < r ? xcd * (q + 1) : r * (q + 1) + (xcd - r) * q) + off; }
        const int nig = WGM * nN, gid = wgid / nig, fm = gid * WGM, gsz = (nM - fm) < WGM ? (nM - fm) : WGM;
        u.pm = fm + ((wgid % nig) % gsz); u.pn = (wgid % nig) / gsz; return true;
    }
    __device__ __forceinline__ void a_ready(const Unit&) const {}
    __device__ __forceinline__ void done(const Unit&) const {}
};
__device__ __forceinline__ unsigned cvt_pk_bf16(float lo, float hi) { unsigned r; asm volatile("v_cvt_pk_bf16_f32 %0, %1, %2" : "=v"(r) : "v"(lo), "v"(hi)); return r; }
template <class Epi, class Sched, bool STAMP = false>
__device__ __forceinline__ void gemm_phase(PG8_LAS unsigned char* lds, const Gemm g, const Sched& S, const Epi& E, unsigned long long* stamps) {
    int tid_o = threadIdx.x; asm volatile("" : "+v"(tid_o)); const int tid = tid_o, wid = __builtin_amdgcn_readfirstlane(tid >> 6), lane = tid & 63, wr = wid >> 2, wc = wid & 3, fr = lane & 15, fq = lane >> 4;
    const int K = g.K, nt = K / BK;
    int ts_lo = 0, ts_hi = 0, nts = 0; const unsigned long long rt_entry = STAMP ? (unsigned long long)wall_clock64() : 0ull;
#define PG8_STAMP() do { if (STAMP && wid == 0 && nts < 64) { const unsigned long long _c = (unsigned long long)clock64(); \
        ts_lo = (lane == nts) ? (int)(unsigned)_c : ts_lo; ts_hi = (lane == nts) ? (int)(unsigned)(_c >> 32) : ts_hi; ++nts; } } while (0)
    PG8_STAMP();
    unsigned voffA[2], voffB[2];
#pragma unroll
    for (int i = 0; i < 2; ++i) { int R, C; stage_rc(tid * 16 + i * 8192, R, C); const int Rb = Epi::PERM ? ((R & ~31) + perm32(R & 31)) : R;
        voffA[i] = (unsigned)(R * g.lda + C) * 2u; voffB[i] = (unsigned)(Rb * K + C) * 2u; }
    const size_t kstep = (size_t)(BK * 2);
    const size_t hstepB = (size_t)HALF * K * 2, hstepA = (size_t)HALF * g.lda * 2;
    const size_t tstepA = 2 * hstepA, tstepB = 2 * hstepB;
    const unsigned ldsw = (unsigned)wid * 1024u;
    const int aoff = lds_byte(wr * 64 + fr, fq * 8), boff = lds_byte(wc * 32 + fr, fq * 8);
#define PG8_SA(b, h) (((b) * 2 + (h)) * HTB)
#define PG8_SB(b, h) ((4 + (b) * 2 + (h)) * HTB)
#define PG8_STAGE(bufoff, gbase, voff) do { _Pragma("unroll") for (int _i = 0; _i < 2; ++_i) \
        __builtin_amdgcn_global_load_lds((const unsigned*)((const char*)(gbase) + (voff)[_i]), (PG8_LAS unsigned*)(lds + (bufoff) + ldsw + _i * 8192), 16, 0, 0); } while (0)
#define PG8_LDA(dst, b, h) do { _Pragma("unroll") for (int m = 0; m < 4; ++m) _Pragma("unroll") for (int k = 0; k < 2; ++k) dst[m][k] = *(const PG8_LAS bf16x8*)(lds + PG8_SA(b, h) + aoff + m * 2048 + k * 1024); } while (0)
#define PG8_LDB(dst, b, h) do { _Pragma("unroll") for (int n = 0; n < 2; ++n) _Pragma("unroll") for (int k = 0; k < 2; ++k) dst[n][k] = *(const PG8_LAS bf16x8*)(lds + PG8_SB(b, h) + boff + n * 2048 + k * 1024); } while (0)
#define PG8_MMA(ai, bj, At, Bt) do { __builtin_amdgcn_s_setprio(1); _Pragma("unroll") for (int m = 0; m < 4; ++m) _Pragma("unroll") for (int n = 0; n < 2; ++n) _Pragma("unroll") for (int k = 0; k < 2; ++k) \
        acc[ai][bj][m][n] = __builtin_amdgcn_mfma_f32_16x16x32_bf16(Bt[n][k], At[m][k], acc[ai][bj][m][n], 0, 0, 0); __builtin_amdgcn_s_setprio(0); } while (0)
#define PG8_WAIT_V(n) asm volatile("s_waitcnt vmcnt(" #n ")" ::: "memory")
#define PG8_WAIT_L(n) asm volatile("s_waitcnt lgkmcnt(" #n ")" ::: "memory")
#define PG8_BAR __builtin_amdgcn_s_barrier()
#define PG8_SCHED __builtin_amdgcn_sched_barrier(0)
    Unit cur, nxt; int ui = 0;
    if (!S.next(0, cur)) return;
    f32x4 acc[2][2][4][2];
#pragma unroll
    for (int a = 0; a < 2; ++a)
#pragma unroll
        for (int b = 0; b < 2; ++b)
#pragma unroll
            for (int m = 0; m < 4; ++m)
#pragma unroll
                for (int n = 0; n < 2; ++n) acc[a][b][m][n] = (f32x4){0.f, 0.f, 0.f, 0.f};
    bf16x8 At[4][2], B0[2][2], B1[2][2];
    const char* cA = (const char*)g.A + (size_t)cur.pm * tstepA; const char* cB = (const char*)g.Bt + (size_t)cur.pn * tstepB;
    S.a_ready(cur);
    PG8_STAGE(PG8_SB(0, 0), cB, voffB); PG8_STAGE(PG8_SA(0, 0), cA, voffA); PG8_STAGE(PG8_SB(0, 1), cB + hstepB, voffB); PG8_STAGE(PG8_SA(0, 1), cA + hstepA, voffA);
    if (wr == 1) PG8_BAR;
    PG8_WAIT_V(4); PG8_BAR;
    PG8_STAGE(PG8_SB(1, 0), cB + kstep, voffB); PG8_STAGE(PG8_SA(1, 0), cA + kstep, voffA); PG8_STAGE(PG8_SB(1, 1), cB + hstepB + kstep, voffB);
    PG8_WAIT_V(6); PG8_BAR;
    PG8_STAMP();
    for (;;) {
        const bool has_next = S.next(ui + 1, nxt);
        const char* nA = has_next ? (const char*)g.A + (size_t)nxt.pm * tstepA : cA; const char* nB = has_next ? (const char*)g.Bt + (size_t)nxt.pn * tstepB : cB;
        for (int t = 0; t < nt; t += 2) {
            const bool last = (t == nt - 2);
            const char* a1 = cA + (size_t)(t + 1) * kstep;
            const char* a2 = last ? nA : cA + (size_t)(t + 2) * kstep; const char* b2 = last ? nB : cB + (size_t)(t + 2) * kstep;
            const char* a3 = a2 + kstep; const char* b3 = b2 + kstep;
            if (last && has_next) S.a_ready(nxt);
            PG8_LDB(B0, 0, 0); PG8_SCHED; PG8_LDA(At, 0, 0); PG8_STAGE(PG8_SA(1, 1), a1 + hstepA, voffA);
            PG8_WAIT_L(8); PG8_BAR; PG8_WAIT_L(0); PG8_MMA(0, 0, At, B0); PG8_BAR; PG8_SCHED;
            PG8_LDB(B1, 0, 1); PG8_STAGE(PG8_SB(0, 0), b2, voffB);
            PG8_BAR; PG8_WAIT_L(0); PG8_MMA(0, 1, At, B1); PG8_BAR;
            PG8_LDA(At, 0, 1); PG8_STAGE(PG8_SA(0, 0), a2, voffA);
            PG8_BAR; PG8_WAIT_L(0); PG8_MMA(1, 0, At, B0); PG8_BAR; PG8_SCHED;
            PG8_STAGE(PG8_SB(0, 1), b2 + hstepB, voffB);
            PG8_WAIT_V(6); PG8_BAR; PG8_MMA(1, 1, At, B1); PG8_BAR;
            PG8_LDB(B0, 1, 0); PG8_SCHED; PG8_LDA(At, 1, 0); PG8_STAGE(PG8_SA(0, 1), a2 + hstepA, voffA);
            PG8_WAIT_L(8); PG8_BAR; PG8_WAIT_L(0); PG8_MMA(0, 0, At, B0); PG8_BAR; PG8_SCHED;
            PG8_LDB(B1, 1, 1); PG8_STAGE(PG8_SB(1, 0), b3, voffB);
            PG8_BAR; PG8_WAIT_L(0); PG8_MMA(0, 1, At, B1); PG8_BAR;
            PG8_LDA(At, 1, 1); PG8_STAGE(PG8_SA(1, 0), a3, voffA);
            PG8_BAR; PG8_WAIT_L(0); PG8_MMA(1, 0, At, B0); PG8_BAR; PG8_SCHED;
            PG8_STAGE(PG8_SB(1, 1), b3 + hstepB, voffB);
            PG8_WAIT_V(6); PG8_BAR; PG8_MMA(1, 1, At, B1); PG8_BAR;
        }
        PG8_STAMP();
        if constexpr (!Epi::AFTER_DRAIN) { E(acc, cur, wr, wc, fr, fq); S.done(cur); }
        PG8_STAMP();
        if (!has_next) break;
#pragma unroll
        for (int a = 0; a < 2; ++a)
#pragma unroll
            for (int b = 0; b < 2; ++b)
#pragma unroll
                for (int m = 0; m < 4; ++m)
#pragma unroll
                    for (int n = 0; n < 2; ++n) acc[a][b][m][n] = (f32x4){0.f, 0.f, 0.f, 0.f};
        cur = nxt; cA = nA; cB = nB; ++ui;
    }
    PG8_WAIT_V(0);
    if (wr == 0) PG8_BAR;
    PG8_BAR;
    if constexpr (Epi::AFTER_DRAIN) { E.fused(acc, cur, wr, wc, fr, fq, lds, wid, lane); S.done(cur); }
    PG8_STAMP();
    if (STAMP && wid == 0) { stamps[lane] = lane < nts ? (((unsigned long long)(unsigned)ts_hi << 32) | (unsigned)ts_lo) : 0ull;
        if (lane == 62) stamps[62] = rt_entry; if (lane == 63) stamps[63] = (unsigned long long)wall_clock64(); }
#undef PG8_STAMP
#undef PG8_SA
#undef PG8_SB
#undef PG8_STAGE
#undef PG8_LDA
#undef PG8_LDB
#undef PG8_MMA
#undef PG8_WAIT_V
#undef PG8_WAIT_L
#undef PG8_BAR
#undef PG8_SCHED
}
}
#define LAS __attribute__((address_space(3)))
#define DI __device__ __forceinline__
using pg8::bf16_t; using pg8::bf16x8; using pg8::f32x4; using pg8::u32x4;
typedef unsigned u32x2 __attribute__((ext_vector_type(2)));

constexpr int T_ = 16384, D_ = 1024, FF_ = 2816, L_ = 4096;
constexpr int ABW = 4352, CDW = 3840;
constexpr float DN_ALPHA = 1.41421356237f, EPS_ = 1e-5f;
constexpr int LDS_BYTES = 144 * 1024;

constexpr size_t SZ_WGU = (size_t)5632 * 1024 * 2, SZ_WD = (size_t)1024 * 2816 * 2, SZ_W1K = (size_t)1024 * 1024 * 2, SZ_WPP = (size_t)1024 * 256 * 2;
constexpr size_t OFF_WGU = 0;
constexpr size_t OFF_WD = OFF_WGU + 4 * SZ_WGU;
constexpr size_t OFF_WPG = OFF_WD + 4 * SZ_WD;
constexpr size_t OFF_WPP = OFF_WPG + 2 * SZ_W1K;
constexpr size_t OFF_WABIN = OFF_WPP + 2 * SZ_WPP;
constexpr size_t OFF_WABOUT = OFF_WABIN + (size_t)ABW * 1024 * 2;
constexpr size_t OFF_WGLU = OFF_WABOUT + (size_t)1024 * 2048 * 2;
constexpr size_t OFF_WCDIN = OFF_WGLU + SZ_W1K;
constexpr size_t OFF_WCDOUT = OFF_WCDIN + (size_t)CDW * 1024 * 2;
constexpr size_t OFF_XB = OFF_WCDOUT + SZ_W1K;
constexpr size_t OFF_BIG = OFF_XB + (size_t)T_ * 1024 * 2;
constexpr size_t SZ_BIG = (size_t)T_ * ABW * 2;
constexpr size_t OFF_PB = OFF_BIG + (size_t)T_ * FF_ * 2;
constexpr size_t OFF_S5L = OFF_BIG + SZ_BIG;
constexpr size_t OFF_S5B = OFF_S5L + 64 * 64 * 2 * 4;
constexpr size_t WS_END = OFF_S5B + (size_t)64 * 128 * 16 * 4;

DI int otid() { int t = threadIdx.x; asm volatile("" : "+v"(t)); return t; }
struct Params { const float* in[34]; float* out; unsigned char* ws; };

DI unsigned pk2(float lo, float hi) { unsigned r; asm("v_cvt_pk_bf16_f32 %0, %1, %2" : "=v"(r) : "v"(lo), "v"(hi)); return r; }
DI float bflo(unsigned w) { return __uint_as_float(w << 16); }
DI float bfhi(unsigned w) { return __uint_as_float(w & 0xffff0000u); }
DI float bf2f(bf16_t b) { return __uint_as_float(((unsigned)b) << 16); }
DI bf16_t f2bf(float f) { return (bf16_t)(pk2(f, 0.f) & 0xffffu); }
DI float sigm(float x) { return 1.f / (1.f + __expf(-x)); }
DI float silu(float x) { return x / (1.f + __expf(-x)); }
DI float softplus(float x) { return x > 20.f ? x : log1pf(__expf(x)); }
DI float logsigm(float x) { return fminf(x, 0.f) - log1pf(__expf(-fabsf(x))); }
DI float gelu_t(float x) { const float u = 0.7978845608f * (x + 0.044715f * x * x * x); return x / (1.f + __expf(-2.f * u)); }

typedef const f32x4 (&AccT)[2][2][4][2];
struct EpiSwiGLU { static constexpr bool PERM = false, AFTER_DRAIN = false; bf16_t* H;
    DI void operator()(AccT acc, const pg8::Unit& u, int wr, int wc, int fr, int fq) const {
        const int row0 = u.pm * 256 + wr * 64 + fr, col0 = u.pn * 128 + wc * 32 + 4 * fq;
#pragma unroll
        for (int ai = 0; ai < 2; ++ai)
#pragma unroll
            for (int m = 0; m < 4; ++m) { bf16_t* rowp = H + (size_t)(row0 + ai * 128 + m * 16) * FF_ + col0;
#pragma unroll
                for (int n = 0; n < 2; ++n) { const f32x4 g = acc[ai][0][m][n], v = acc[ai][1][m][n]; u32x2 w;
                    w.x = pk2(silu(g[0]) * v[0], silu(g[1]) * v[1]); w.y = pk2(silu(g[2]) * v[2], silu(g[3]) * v[3]); *(u32x2*)(rowp + n * 16) = w; } }
    } };
struct EpiRes { static constexpr bool PERM = false, AFTER_DRAIN = false; const float* base; float* out; float scale;
    DI void operator()(AccT acc, const pg8::Unit& u, int wr, int wc, int fr, int fq) const {
        const int row0 = u.pm * 256 + wr * 64 + fr, col0 = u.pn * 256 + wc * 32 + 4 * fq;
#pragma unroll
        for (int ai = 0; ai < 2; ++ai)
#pragma unroll
            for (int m = 0; m < 4; ++m) { const size_t off = (size_t)(row0 + ai * 128 + m * 16) * D_ + col0;
#pragma unroll
                for (int bj = 0; bj < 2; ++bj)
#pragma unroll
                    for (int n = 0; n < 2; ++n) { const size_t o = off + bj * 128 + n * 16; const f32x4 b = *(const f32x4*)(base + o); *(f32x4*)(out + o) = b * DN_ALPHA + acc[ai][bj][m][n] * scale; } }
    } };
struct EpiBf16 { static constexpr bool PERM = false, AFTER_DRAIN = false; bf16_t* O; int ldc;
    DI void operator()(AccT acc, const pg8::Unit& u, int wr, int wc, int fr, int fq) const {
        const int row0 = u.pm * 256 + wr * 64 + fr, col0 = u.pn * 256 + wc * 32 + 4 * fq;
#pragma unroll
        for (int ai = 0; ai < 2; ++ai)
#pragma unroll
            for (int m = 0; m < 4; ++m) { bf16_t* rowp = O + (size_t)(row0 + ai * 128 + m * 16) * ldc + col0;
#pragma unroll
                for (int bj = 0; bj < 2; ++bj)
#pragma unroll
                    for (int n = 0; n < 2; ++n) { const f32x4 v = acc[ai][bj][m][n]; u32x2 w; w.x = pk2(v[0], v[1]); w.y = pk2(v[2], v[3]); *(u32x2*)(rowp + bj * 128 + n * 16) = w; } }
    } };
struct EpiGLU { static constexpr bool PERM = false, AFTER_DRAIN = false; const bf16_t* G; bf16_t* Y; const float* bias;
    DI void operator()(AccT acc, const pg8::Unit& u, int wr, int wc, int fr, int fq) const {
        const int row0 = u.pm * 256 + wr * 64 + fr, col0 = u.pn * 256 + wc * 32 + 4 * fq;
#pragma unroll
        for (int ai = 0; ai < 2; ++ai)
#pragma unroll
            for (int m = 0; m < 4; ++m) { const size_t off = (size_t)(row0 + ai * 128 + m * 16) * ABW + col0;
#pragma unroll
                for (int bj = 0; bj < 2; ++bj)
#pragma unroll
                    for (int n = 0; n < 2; ++n) { const int cc = bj * 128 + n * 16; const f32x4 v = acc[ai][bj][m][n]; const f32x4 bv = *(const f32x4*)(bias + col0 + cc);
                        const u32x2 g = *(const u32x2*)(G + off + cc); u32x2 w;
                        w.x = pk2(bflo(g.x) * sigm(v[0] + bv[0]), bfhi(g.x) * sigm(v[1] + bv[1])); w.y = pk2(bflo(g.y) * sigm(v[2] + bv[2]), bfhi(g.y) * sigm(v[3] + bv[3]));
                        *(u32x2*)(Y + off + cc) = w; } }
    } };
struct EpiF32 { static constexpr bool PERM = false, AFTER_DRAIN = false; float* C;
    DI void operator()(AccT acc, const pg8::Unit& u, int wr, int wc, int fr, int fq) const {
        const int row0 = u.pm * 256 + wr * 64 + fr, col0 = u.pn * 256 + wc * 32 + 4 * fq;
#pragma unroll
        for (int ai = 0; ai < 2; ++ai)
#pragma unroll
            for (int m = 0; m < 4; ++m) { const size_t off = (size_t)(row0 + ai * 128 + m * 16) * D_ + col0;
#pragma unroll
                for (int bj = 0; bj < 2; ++bj)
#pragma unroll
                    for (int n = 0; n < 2; ++n) *(f32x4*)(C + off + bj * 128 + n * 16) = acc[ai][bj][m][n]; }
    } };
struct EpiPLE { static constexpr bool PERM = false, AFTER_DRAIN = false; float* X; const float* PP; bf16_t* XB;
    DI void operator()(AccT acc, const pg8::Unit& u, int wr, int wc, int fr, int fq) const {
        const int row0 = u.pm * 256 + wr * 64 + fr, col0 = u.pn * 256 + wc * 32 + 4 * fq;
#pragma unroll
        for (int ai = 0; ai < 2; ++ai)
#pragma unroll
            for (int m = 0; m < 4; ++m) { const size_t off = (size_t)(row0 + ai * 128 + m * 16) * D_ + col0;
#pragma unroll
                for (int bj = 0; bj < 2; ++bj)
#pragma unroll
                    for (int n = 0; n < 2; ++n) { const size_t o = off + bj * 128 + n * 16; const f32x4 a = acc[ai][bj][m][n]; const f32x4 x = *(const f32x4*)(X + o), pp = *(const f32x4*)(PP + o); f32x4 r;
#pragma unroll
                        for (int j = 0; j < 4; ++j) r[j] = x[j] + sigm(a[j]) * pp[j];
                        *(f32x4*)(X + o) = r; u32x2 w; w.x = pk2(r[0], r[1]); w.y = pk2(r[2], r[3]); *(u32x2*)(XB + o) = w; } }
    } };

template <class Epi> DI void run_gemm(LAS unsigned char* lds, const bf16_t* A, int lda, const bf16_t* Bt, int N, int K, const Epi& E) {
    pg8::Gemm g{A, Bt, T_, N, K, lda}; pg8::StaticOrder S; S.init(T_, N, (int)gridDim.x, (int)blockIdx.x);
    pg8::gemm_phase<Epi, pg8::StaticOrder, false>(lds, g, S, E, nullptr);
}
struct Job { const float* src; bf16_t* dst; int K, N, map; };
DI int mapn(int map, int n) {
    if (map == 0) return n;
    if (map == 1) return 256 * (n >> 7) + (n & 127);
    if (map == 2) return 256 * (n >> 7) + 128 + (n & 127);
    if (map == 3) return n < 3072 ? n : (n < 3088 ? n + 1024 : n - 16);
    return n < 1536 ? n + 1024 : (n < 2048 ? n - 1536 : (n < 3088 ? n + 512 : n - 2576));
}
DI Job get_job(const Params& P, int j) {
    unsigned char* ws = P.ws; Job J;
    if (j < 4)       { J.src = P.in[4] + (size_t)j * 1024 * 2816;        J.dst = (bf16_t*)(ws + OFF_WGU + j * SZ_WGU);        J.K = 1024; J.N = 2816; J.map = 1; }
    else if (j < 8)  { J.src = P.in[5] + (size_t)(j - 4) * 1024 * 2816;  J.dst = (bf16_t*)(ws + OFF_WGU + (j - 4) * SZ_WGU);  J.K = 1024; J.N = 2816; J.map = 2; }
    else if (j < 12) { J.src = P.in[6] + (size_t)(j - 8) * 2816 * 1024;  J.dst = (bf16_t*)(ws + OFF_WD + (j - 8) * SZ_WD);    J.K = 2816; J.N = 1024; J.map = 0; }
    else if (j < 14) { J.src = P.in[7] + (size_t)(j - 12) * 1024 * 1024; J.dst = (bf16_t*)(ws + OFF_WPG + (j - 12) * SZ_W1K); J.K = 1024; J.N = 1024; J.map = 0; }
    else if (j < 16) { J.src = P.in[8] + (size_t)(j - 14) * 256 * 1024;  J.dst = (bf16_t*)(ws + OFF_WPP + (j - 14) * SZ_WPP); J.K = 256;  J.N = 1024; J.map = 0; }
    else if (j == 16) { J.src = P.in[9];  J.dst = (bf16_t*)(ws + OFF_WABIN);  J.K = 1024; J.N = 4112; J.map = 3; }
    else if (j == 17) { J.src = P.in[10]; J.dst = (bf16_t*)(ws + OFF_WABOUT); J.K = 2048; J.N = 1024; J.map = 0; }
    else if (j == 18) { J.src = P.in[25]; J.dst = (bf16_t*)(ws + OFF_WGLU);   J.K = 1024; J.N = 1024; J.map = 0; }
    else if (j == 19) { J.src = P.in[27]; J.dst = (bf16_t*)(ws + OFF_WCDIN);  J.K = 1024; J.N = 3600; J.map = 4; }
    else              { J.src = P.in[28]; J.dst = (bf16_t*)(ws + OFF_WCDOUT); J.K = 1024; J.N = 1024; J.map = 0; }
    return J;
}
DI void convT_tile(LAS bf16_t* tl, const Job& J, int tile) {
    const int ntn = (J.N + 63) >> 6, tk = tile / ntn, tn = tile - tk * ntn, k0 = tk * 64, n0 = tn * 64, tid = otid();
    const int n4 = (tid & 15) * 4, kr = tid >> 4;
    if (n0 + n4 < J.N) {
#pragma unroll
        for (int ps = 0; ps < 2; ++ps) { const int k = kr + 32 * ps; const f32x4 v = *(const f32x4*)(J.src + (size_t)(k0 + k) * J.N + n0 + n4);
#pragma unroll
            for (int i = 0; i < 4; ++i) tl[(n4 + i) * 72 + k] = f2bf(v[i]); }
    }
    __syncthreads();
    const int n = tid >> 3, kg = tid & 7;
    if (n0 + n < J.N) { const u32x4 w = *(const LAS u32x4*)(tl + n * 72 + kg * 8); *(u32x4*)(J.dst + (size_t)mapn(J.map, n0 + n) * J.K + k0 + kg * 8) = w; }
    __syncthreads();
}
DI void sincos_d(double x, double& s, double& c) {
    const double kq = rint(x * 0.63661977236758134308); const double r = x - kq * 1.57079632679489661923; const double r2 = r * r;
    const double sr = r * (1.0 - r2 / 6.0 * (1.0 - r2 / 20.0 * (1.0 - r2 / 42.0 * (1.0 - r2 / 72.0 * (1.0 - r2 / 110.0 * (1.0 - r2 / 156.0 * (1.0 - r2 / 210.0)))))));
    const double cr = 1.0 - r2 / 2.0 * (1.0 - r2 / 12.0 * (1.0 - r2 / 30.0 * (1.0 - r2 / 56.0 * (1.0 - r2 / 90.0 * (1.0 - r2 / 132.0 * (1.0 - r2 / 182.0 * (1.0 - r2 / 240.0)))))));
    const int qd = ((int)kq) & 3;
    s = qd == 0 ? sr : (qd == 1 ? cr : (qd == 2 ? -sr : -cr)); c = qd == 0 ? cr : (qd == 1 ? -sr : (qd == 2 ? -cr : sr));
}
DI double exp_d(double x) { const double y = x * 0.015625; double e = 1.0 + y * (1.0 + y / 2.0 * (1.0 + y / 3.0 * (1.0 + y / 4.0 * (1.0 + y / 5.0 * (1.0 + y / 6.0 * (1.0 + y / 7.0 * (1.0 + y / 8.0 * (1.0 + y / 9.0 * (1.0 + y / 10.0))))))))); e *= e; e *= e; e *= e; e *= e; e *= e; e *= e; return e; }
DI void p0_phase(const Params& P, LAS unsigned char* lds) {
    const int tid = otid(), G = gridDim.x, bid = blockIdx.x;
    {
        int base = 0;
        for (int j = 0; j < 21; ++j) { const Job J = get_job(P, j); const int nt = (J.K >> 6) * ((J.N + 63) >> 6);
            int first = (bid - base % G + G) % G;
            for (int t = first; t < nt; t += G) convT_tile((LAS bf16_t*)lds, J, t);
            base += nt; }
    }
    const size_t gt = (size_t)bid * 512 + tid, gs = (size_t)G * 512;
    { u32x4 z = {0u, 0u, 0u, 0u}; u32x4* a = (u32x4*)(P.ws + OFF_WABIN + (size_t)4112 * 1024 * 2); for (size_t i = gt; i < (size_t)240 * 1024 * 2 / 16; i += gs) a[i] = z;
      u32x4* c = (u32x4*)(P.ws + OFF_WCDIN + (size_t)3600 * 1024 * 2); for (size_t i = gt; i < (size_t)240 * 1024 * 2 / 16; i += gs) c[i] = z; }
    { const f32x4* x = (const f32x4*)P.in[0]; u32x2* xb = (u32x2*)(P.ws + OFF_XB); for (size_t i = gt; i < (size_t)T_ * D_ / 4; i += gs) { const f32x4 v = x[i]; u32x2 w; w.x = pk2(v[0], v[1]); w.y = pk2(v[2], v[3]); xb[i] = w; } }
    for (size_t i = gt; i < 64 * 64; i += gs) { const int g = (int)(i >> 6), n = (int)(i & 63);
        const double dt = exp_d((double)P.in[19][g]);
        const double lr = (double)P.in[17][i], li = (double)P.in[18][i];
        const double e = exp_d(lr * dt); double sn, cs; sincos_d(li * dt, sn, cs); const double lbr = e * cs, lbi = e * sn;
        const double den = lr * lr + li * li, cr = ((lbr - 1.0) * lr + lbi * li) / den, ci = (lbi * lr - (lbr - 1.0) * li) / den;
        float* lt = (float*)(P.ws + OFF_S5L); lt[i * 2] = (float)lbr; lt[i * 2 + 1] = (float)lbi;
        float* bt = (float*)(P.ws + OFF_S5B) + (size_t)g * 128 * 16;
        for (int q = 0; q < 16; ++q) { const double br = (double)P.in[20][i * 16 + q], bi = (double)P.in[21][i * 16 + q]; bt[n * 16 + q] = (float)(cr * br - ci * bi); bt[(64 + n) * 16 + q] = (float)(cr * bi + ci * br); } }
}
DI float wave_sum(float v) { v += __shfl_xor(v, 32); v += __shfl_xor(v, 16); v += __shfl_xor(v, 8); v += __shfl_xor(v, 4); v += __shfl_xor(v, 2); v += __shfl_xor(v, 1); return v; }
DI void ln_phase(float* X, bf16_t* XB, const float* g, const float* b) {
    const int wave = otid() >> 6, lane = otid() & 63;
    for (int row = blockIdx.x * 8 + wave; row < T_; row += gridDim.x * 8) {
        float* r = X + (size_t)row * D_; f32x4 v[4]; float s = 0.f;
#pragma unroll
        for (int i = 0; i < 4; ++i) { v[i] = *(const f32x4*)(r + i * 256 + lane * 4); s += (v[i][0] + v[i][1]) + (v[i][2] + v[i][3]); }
        const float mean = wave_sum(s) * (1.f / 1024.f); float q = 0.f;
#pragma unroll
        for (int i = 0; i < 4; ++i) { v[i] = v[i] - mean; q += (v[i][0] * v[i][0] + v[i][1] * v[i][1]) + (v[i][2] * v[i][2] + v[i][3] * v[i][3]); }
        const float rstd = 1.0f / sqrtf(wave_sum(q) * (1.f / 1024.f) + EPS_);
#pragma unroll
        for (int i = 0; i < 4; ++i) { const f32x4 gg = *(const f32x4*)(g + i * 256 + lane * 4), bb = *(const f32x4*)(b + i * 256 + lane * 4); const f32x4 o = v[i] * rstd * gg + bb;
            *(f32x4*)(r + i * 256 + lane * 4) = o; u32x2 w; w.x = pk2(o[0], o[1]); w.y = pk2(o[2], o[3]); *(u32x2*)(XB + (size_t)row * D_ + i * 256 + lane * 4) = w; }
    }
}
DI void p_to_bf16(const float* p, bf16_t* pb) {
    const size_t gt = (size_t)blockIdx.x * 512 + otid(), gs = (size_t)gridDim.x * 512;
    for (size_t i = gt; i < (size_t)T_ * 256 / 4; i += gs) { const f32x4 v = ((const f32x4*)p)[i]; u32x2 w; w.x = pk2(v[0], v[1]); w.y = pk2(v[2], v[3]); ((u32x2*)pb)[i] = w; }
}
DI void ssd_rms_phase(bf16_t* BIG, const float* nw) {
    const int wave = otid() >> 6, lane = otid() & 63;
    for (int row = blockIdx.x * 8 + wave; row < T_; row += gridDim.x * 8) {
        bf16_t* r = BIG + (size_t)row * ABW + lane * 16; const u32x4 a = *(const u32x4*)r, c = *(const u32x4*)(r + 8);
        float v[16]; v[0] = bflo(a.x); v[1] = bfhi(a.x); v[2] = bflo(a.y); v[3] = bfhi(a.y); v[4] = bflo(a.z); v[5] = bfhi(a.z); v[6] = bflo(a.w); v[7] = bfhi(a.w);
        v[8] = bflo(c.x); v[9] = bfhi(c.x); v[10] = bflo(c.y); v[11] = bfhi(c.y); v[12] = bflo(c.z); v[13] = bfhi(c.z); v[14] = bflo(c.w); v[15] = bfhi(c.w);
        float s = 0.f;
#pragma unroll
        for (int i = 0; i < 16; ++i) s += v[i] * v[i];
        s += __shfl_xor(s, 8); s += __shfl_xor(s, 4); s += __shfl_xor(s, 2); s += __shfl_xor(s, 1);
        const float rstd = 1.0f / sqrtf(s * (1.f / 256.f) + EPS_);
        const float* w = nw + lane * 16; u32x4 o0, o1;
        o0.x = pk2(v[0] * rstd * w[0], v[1] * rstd * w[1]); o0.y = pk2(v[2] * rstd * w[2], v[3] * rstd * w[3]); o0.z = pk2(v[4] * rstd * w[4], v[5] * rstd * w[5]); o0.w = pk2(v[6] * rstd * w[6], v[7] * rstd * w[7]);
        o1.x = pk2(v[8] * rstd * w[8], v[9] * rstd * w[9]); o1.y = pk2(v[10] * rstd * w[10], v[11] * rstd * w[11]); o1.z = pk2(v[12] * rstd * w[12], v[13] * rstd * w[13]); o1.w = pk2(v[14] * rstd * w[14], v[15] * rstd * w[15]);
        *(u32x4*)r = o0; *(u32x4*)(r + 8) = o1;
    }
}
template <int KIND> struct Cfg;
template <> struct Cfg<0> { static constexpr int DK = 128, DV = 64, LD = ABW; };
template <> struct Cfg<1> { static constexpr int DK = 128, DV = 128, LD = CDW; };
template <> struct Cfg<2> { static constexpr int DK = 64, DV = 128, LD = CDW; };
#define MFMA16(a, b, c) __builtin_amdgcn_mfma_f32_16x16x32_bf16((a), (b), (c), 0, 0, 0)
#define FRAG(off, row, pitch) (*(const LAS bf16x8*)(lds + (off) + (row) * (pitch) + kb0))
#define ST16(off, val) (*(LAS bf16_t*)(lds + (off)) = (val))

template <int KIND, int MODE, int NS>
DI void cla_item(const Params& P, LAS unsigned char* lds, const int b, const int h, const int seg, float* stbase) {
    constexpr int DK = Cfg<KIND>::DK, DV = Cfg<KIND>::DV, LD = Cfg<KIND>::LD;
    constexpr int PQB = (DK + 8) * 2, P64B = 144;
    constexpr int oQs = 0, oKs = oQs + 64 * PQB, oKh = oKs + 64 * PQB, oVt = oKh + DK * P64B, oST = oVt + DV * P64B, oAt = oST + DV * PQB, oXs = oAt + 64 * P64B,
                  oTot = oXs + 64 * P64B, oEgm = oTot + 8 * 128 * 4, oEgl = oEgm + 512, oAc = oEgl + 512, oRed = oAc + 256;
    static_assert(oRed + 512 <= LDS_BYTES, "cla LDS");
    constexpr int NDT = DK / 16, WPD = 8 / NDT, NVT = DV / 16, NT = NVT / WPD, NVW = DV / 32, KS = DK / 32;
    const int tid = otid(), lane = tid & 63, w = __builtin_amdgcn_readfirstlane(tid >> 6), r16 = lane & 15, q4 = lane >> 4;
    const int lt = w >> 1, wh = w & 1, dti = w / WPD, vt0 = (w % WPD) * NT;
    bf16_t* BIG = (bf16_t*)(P.ws + OFF_BIG) + (size_t)b * L_ * LD;
    LAS float* tot = (LAS float*)(lds + oTot); LAS float* egm = (LAS float*)(lds + oEgm); LAS float* egl = (LAS float*)(lds + oEgl);
    LAS float* acum = (LAS float*)(lds + oAc); LAS float* red = (LAS float*)(lds + oRed);
    f32x4 accS[NT];
#pragma unroll
    for (int i = 0; i < NT; ++i) accS[i] = (f32x4){0.f, 0.f, 0.f, 0.f};
    constexpr int REC = DK * DV + 128;
    float gsum = 0.f;
    if constexpr (MODE == 1) {
        for (int j = 0; j < seg; ++j) { const float* rec = stbase + (size_t)j * REC; const int d0 = 16 * dti + 4 * q4;
            f32x4 e; if constexpr (KIND == 0) { const float e0 = __expf(rec[DK * DV]); e = (f32x4){e0, e0, e0, e0}; } else { const f32x4 gs = *(const f32x4*)(rec + DK * DV + d0); e = (f32x4){__expf(gs[0]), __expf(gs[1]), __expf(gs[2]), __expf(gs[3])}; }
#pragma unroll
            for (int i = 0; i < NT; ++i) accS[i] = accS[i] * e + *(const f32x4*)(rec + ((size_t)(w * NT + i) * 64 + lane) * 4); }
    }
    float c_lb = 0.f, c_bg = 0.f, c_Ah = 0.f, c_dtb = 0.f, c_Dh = 0.f; float wup[16];
#pragma unroll
    for (int r = 0; r < 16; ++r) wup[r] = 0.f;
    if constexpr (KIND == 0) { c_Ah = -__expf(P.in[14][h]); c_dtb = P.in[13][h]; c_Dh = P.in[15][h]; }
    if constexpr (KIND == 1) { const int d = tid & 127; c_lb = sigm(P.in[29][512 + h * 128 + d] - P.in[29][h * 128 + d]); }
    if constexpr (KIND == 2) { const int d = tid & 63; c_bg = P.in[32][h * 64 + d];
#pragma unroll
        for (int r = 0; r < 16; ++r) wup[r] = P.in[31][r * 256 + h * 64 + d]; }

    constexpr int CPS = 64 / NS;
    for (int c = seg * CPS; c < (seg + 1) * CPS; ++c) {
        const int t0 = c * 64;
        float eglS = 1.f;
        if constexpr (KIND == 0) {
            const int g = h >> 2; const float* cw = P.in[11]; const float* cb = P.in[12];
            const int ch = tid & 127, tg = tid >> 7, ts = t0 + tg * 16;
            float breg[16];
#pragma unroll
            for (int which = 0; which < 2; ++which) {
                const int col = (which ? 2560 : 2048) + g * 128 + ch, cc = (which ? 1536 : 1024) + g * 128 + ch;
                const float w0 = cw[cc], w1 = cw[2048 + cc], w2 = cw[4096 + cc], w3 = cw[6144 + cc], bb = cb[cc];
                const bf16_t* src = BIG + (size_t)ts * LD + col;
                float x0 = 0.f, x1 = 0.f, x2 = 0.f;
                if (ts > 0) { x0 = bf2f(src[-3 * LD]); x1 = bf2f(src[-2 * LD]); x2 = bf2f(src[-LD]); }
#pragma unroll
                for (int i = 0; i < 16; ++i) { const float x3 = bf2f(src[i * LD]); const float v = silu(w0 * x0 + w1 * x1 + w2 * x2 + w3 * x3 + bb); x0 = x1; x1 = x2; x2 = x3;
                    if (which) ST16(oQs + (tg * 16 + i) * PQB + ch * 2, f2bf(v)); else { ST16(oKs + (tg * 16 + i) * PQB + ch * 2, f2bf(v)); breg[i] = v; } }
            }
            {
                const int p = tid & 63, tg2 = tid >> 6, ts2 = t0 + tg2 * 8, cc = h * 64 + p;
                const float w0 = cw[cc], w1 = cw[2048 + cc], w2 = cw[4096 + cc], w3 = cw[6144 + cc], bb = cb[cc];
                const bf16_t* src = BIG + (size_t)ts2 * LD + 1024 + cc; const bf16_t* dsrc = BIG + (size_t)ts2 * LD + 4096 + h;
                float x0 = 0.f, x1 = 0.f, x2 = 0.f;
                if (ts2 > 0) { x0 = bf2f(src[-3 * LD]); x1 = bf2f(src[-2 * LD]); x2 = bf2f(src[-LD]); }
#pragma unroll
                for (int i = 0; i < 8; ++i) { const float x3 = bf2f(src[i * LD]); const float v = silu(w0 * x0 + w1 * x1 + w2 * x2 + w3 * x3 + bb); x0 = x1; x1 = x2; x2 = x3;
                    const float dtv = softplus(bf2f(dsrc[i * LD]) + c_dtb);
                    ST16(oVt + p * P64B + (tg2 * 8 + i) * 2, f2bf(v * dtv)); ST16(oXs + (tg2 * 8 + i) * P64B + p * 2, f2bf(v)); }
            }
            if (w == 0) { float a = softplus(bf2f(BIG[(size_t)(t0 + lane) * LD + 4096 + h]) + c_dtb) * c_Ah;
#pragma unroll
                for (int o = 1; o < 64; o <<= 1) { const float t = __shfl_up(a, o); if (lane >= o) a += t; }
                acum[lane] = a; }
            __syncthreads();
            const float alast = acum[63]; eglS = __expf(alast); gsum += alast;
#pragma unroll
            for (int i = 0; i < 16; ++i) ST16(oKh + ch * P64B + (tg * 16 + i) * 2, f2bf(breg[i] * __expf(alast - acum[tg * 16 + i])));
            __syncthreads();
        }
        if constexpr (KIND == 1) {
            const int d = tid & 127, tg = tid >> 7, ts = t0 + tg * 16;
            float qv[16], kv[16], cv[16]; float cum = 0.f;
            const bf16_t* src = BIG + (size_t)ts * LD + h * 128 + d;
#pragma unroll
            for (int i = 0; i < 16; ++i) { const float qr = bf2f(src[i * LD + 1024]), fl = bf2f(src[i * LD + 1536]); const bf16_t vr = src[i * LD + 2048];
                const float kk = (1.f - c_lb) * sigm(-fl); cum += __logf(1.f - kk); qv[i] = silu(qr); kv[i] = kk; cv[i] = cum; ST16(oVt + d * P64B + (tg * 16 + i) * 2, vr); }
            tot[tg * 128 + d] = cum;
            __syncthreads();
            const float t0v = tot[d], t1v = tot[128 + d], t2v = tot[256 + d], t3v = tot[384 + d];
            const float off = (tg > 0 ? t0v : 0.f) + (tg > 1 ? t1v : 0.f) + (tg > 2 ? t2v : 0.f), gm = t0v + t1v, gl = gm + t2v + t3v;
#pragma unroll
            for (int i = 0; i < 16; ++i) { const float g = off + cv[i]; const int tl = tg * 16 + i;
                ST16(oQs + tl * PQB + d * 2, f2bf(qv[i] * __expf(g - gm))); ST16(oKs + tl * PQB + d * 2, f2bf(kv[i] * __expf(gm - g))); ST16(oKh + d * P64B + tl * 2, f2bf(kv[i] * __expf(gl - g))); }
            if (tg == 0) { egm[d] = __expf(gm); egl[d] = __expf(gl); gsum += gl; }
            __syncthreads();
        }
        if constexpr (KIND == 2) {
            const int d = tid & 63, tg = tid >> 6, ts = t0 + tg * 8;
            float qv[8], kv[8], cv[8]; float cum = 0.f;
            const bf16_t* src = BIG + (size_t)ts * LD;
#pragma unroll
            for (int i = 0; i < 8; ++i) { const bf16_t* row = src + i * LD; const float qr = bf2f(row[2560 + h * 64 + d]) * 0.125f, kr = bf2f(row[2816 + h * 64 + d]);
                const u32x4 ga = *(const u32x4*)(row + 3584), gb = *(const u32x4*)(row + 3592);
                float lg = c_bg;
                lg += bflo(ga.x) * wup[0] + bfhi(ga.x) * wup[1] + bflo(ga.y) * wup[2] + bfhi(ga.y) * wup[3] + bflo(ga.z) * wup[4] + bfhi(ga.z) * wup[5] + bflo(ga.w) * wup[6] + bfhi(ga.w) * wup[7];
                lg += bflo(gb.x) * wup[8] + bfhi(gb.x) * wup[9] + bflo(gb.y) * wup[10] + bfhi(gb.y) * wup[11] + bflo(gb.z) * wup[12] + bfhi(gb.z) * wup[13] + bflo(gb.w) * wup[14] + bfhi(gb.w) * wup[15];
                cum += logsigm(lg) * 0.0625f; qv[i] = qr; kv[i] = kr; cv[i] = cum; }
            tot[tg * 128 + d] = cum;
            { const int v = tid & 127, tgv = tid >> 7; const bf16_t* vs = BIG + (size_t)(t0 + tgv * 16) * LD + 3072 + h * 128 + v;
#pragma unroll
                for (int i = 0; i < 16; ++i) ST16(oVt + v * P64B + (tgv * 16 + i) * 2, vs[i * LD]); }
            __syncthreads();
            float off = 0.f, gm = 0.f, gl = 0.f;
#pragma unroll
            for (int g2 = 0; g2 < 8; ++g2) { const float tv = tot[g2 * 128 + d]; if (g2 < tg) off += tv; if (g2 < 4) gm += tv; gl += tv; }
#pragma unroll
            for (int i = 0; i < 8; ++i) { const float g = off + cv[i]; const int tl = tg * 8 + i;
                ST16(oQs + tl * PQB + d * 2, f2bf(qv[i] * __expf(g - gm))); ST16(oKs + tl * PQB + d * 2, f2bf(kv[i] * __expf(gm - g))); ST16(oKh + d * P64B + tl * 2, f2bf(kv[i] * __expf(gl - g))); }
            if (tg == 0) { egm[d] = __expf(gm); egl[d] = __expf(gl); gsum += gl; }
            __syncthreads();
        }
        f32x4 accO[NVW]; const int lrow = 16 * lt + r16;
        if constexpr (MODE == 1) {
#pragma unroll
        for (int i = 0; i < NT; ++i) { const int v = 16 * (vt0 + i) + r16, d0 = 16 * dti + 4 * q4; f32x4 s = accS[i];
            if constexpr (KIND != 0) { const f32x4 e = *(const LAS f32x4*)(egm + d0); s = s * e; }
            u32x2 wv; wv.x = pk2(s[0], s[1]); wv.y = pk2(s[2], s[3]); *(LAS u32x2*)(lds + oST + v * PQB + d0 * 2) = wv; }
#pragma unroll
        for (int e = 0; e < 2; ++e) { const int st = 2 * wh + e; f32x4 a = {0.f, 0.f, 0.f, 0.f};
            if (st <= lt) {
#pragma unroll
                for (int ks = 0; ks < KS; ++ks) { const int kb0 = ks * 64 + q4 * 16; a = MFMA16(FRAG(oKs, 16 * st + r16, PQB), FRAG(oQs, 16 * lt + r16, PQB), a); }
                const int l = 16 * lt + r16, s0 = 16 * st + 4 * q4;
#pragma unroll
                for (int j = 0; j < 4; ++j) { float dec = 1.f; if constexpr (KIND == 0) dec = __expf(fminf(acum[l] - acum[s0 + j], 0.f)); a[j] = (s0 + j <= l) ? a[j] * dec : 0.f; }
            }
            u32x2 wv; wv.x = pk2(a[0], a[1]); wv.y = pk2(a[2], a[3]); *(LAS u32x2*)(lds + oAt + (16 * lt + r16) * P64B + (16 * st + 4 * q4) * 2) = wv; }
        __syncthreads();
        {
            bf16x8 qf[KS];
#pragma unroll
            for (int ks = 0; ks < KS; ++ks) { const int kb0 = ks * 64 + q4 * 16; qf[ks] = FRAG(oQs, 16 * lt + r16, PQB); }
#pragma unroll
            for (int i = 0; i < NVW; ++i) { const int vt = wh * NVW + i; f32x4 a = {0.f, 0.f, 0.f, 0.f};
#pragma unroll
                for (int ks = 0; ks < KS; ++ks) { const int kb0 = ks * 64 + q4 * 16; a = MFMA16(FRAG(oST, 16 * vt + r16, PQB), qf[ks], a); }
                if constexpr (KIND == 0) a = a * __expf(acum[16 * lt + r16]);
                accO[i] = a; }
#pragma unroll
            for (int ks = 0; ks < 2; ++ks) { if (ks * 32 <= 16 * lt + 15) { const int kb0 = ks * 64 + q4 * 16; const bf16x8 af = FRAG(oAt, 16 * lt + r16, P64B);
#pragma unroll
                for (int i = 0; i < NVW; ++i) accO[i] = MFMA16(FRAG(oVt, 16 * (wh * NVW + i) + r16, P64B), af, accO[i]); } }
        }
        if constexpr (KIND == 0) {
#pragma unroll
            for (int i = 0; i < NVW; ++i) { const int p0 = 16 * (wh * NVW + i) + 4 * q4; bf16_t* zp = BIG + (size_t)(t0 + lrow) * LD + h * 64 + p0;
                const u32x2 z = *(const u32x2*)zp; const u32x2 xs = *(const LAS u32x2*)(lds + oXs + lrow * P64B + p0 * 2); const f32x4 a = accO[i]; u32x2 wv;
                wv.x = pk2((a[0] + c_Dh * bflo(xs.x)) * silu(bflo(z.x)), (a[1] + c_Dh * bfhi(xs.x)) * silu(bfhi(z.x)));
                wv.y = pk2((a[2] + c_Dh * bflo(xs.y)) * silu(bflo(z.y)), (a[3] + c_Dh * bfhi(xs.y)) * silu(bfhi(z.y))); *(u32x2*)zp = wv; }
        } else {
            float ss = 0.f;
#pragma unroll
            for (int i = 0; i < NVW; ++i) ss += (accO[i][0] * accO[i][0] + accO[i][1] * accO[i][1]) + (accO[i][2] * accO[i][2] + accO[i][3] * accO[i][3]);
            ss += __shfl_xor(ss, 16); ss += __shfl_xor(ss, 32);
            if (q4 == 0) red[lrow * 2 + wh] = ss;
        }
        }
#pragma unroll
        for (int i = 0; i < NT; ++i) { const int d0 = 16 * dti + 4 * q4; f32x4 s = accS[i];
            if constexpr (KIND == 0) s = s * eglS; else { const f32x4 e = *(const LAS f32x4*)(egl + d0); s = s * e; }
#pragma unroll
            for (int ks = 0; ks < 2; ++ks) { const int kb0 = ks * 64 + q4 * 16; s = MFMA16(FRAG(oKh, 16 * dti + r16, P64B), FRAG(oVt, 16 * (vt0 + i) + r16, P64B), s); }
            accS[i] = s; }
        __syncthreads();
        if constexpr (KIND != 0 && MODE == 1) {
            const float rstd = 1.0f / sqrtf((red[lrow * 2] + red[lrow * 2 + 1]) * (1.f / 128.f) + EPS_);
            const float* nw = (KIND == 1 ? P.in[30] : P.in[33]) + h * 128; const int gofs = (KIND == 1 ? 0 : 512) + h * 128;
#pragma unroll
            for (int i = 0; i < NVW; ++i) { const int v0 = 16 * (wh * NVW + i) + 4 * q4; bf16_t* gp = BIG + (size_t)(t0 + lrow) * LD + gofs + v0;
                const u32x2 gt = *(const u32x2*)gp; const f32x4 nv = *(const f32x4*)(nw + v0); const f32x4 a = accO[i] * rstd * nv; u32x2 wv;
                wv.x = pk2(a[0] * silu(bflo(gt.x)), a[1] * silu(bfhi(gt.x))); wv.y = pk2(a[2] * silu(bflo(gt.y)), a[3] * silu(bfhi(gt.y))); *(u32x2*)gp = wv; }
        }
    }
    if constexpr (MODE == 0) {
        float* rec = stbase + (size_t)seg * REC;
#pragma unroll
        for (int i = 0; i < NT; ++i) *(f32x4*)(rec + ((size_t)(w * NT + i) * 64 + lane) * 4) = accS[i];
        if constexpr (KIND == 0) { if (tid == 0) rec[DK * DV] = gsum; }
        else { if (tid < DK) rec[DK * DV + tid] = gsum; }
    }
}
template <int MODE>
DI void s5_wave(const Params& P, LAS unsigned char* wl  , const int b, const int g, const int seg, float* hst  ) {
    const int lane = otid() & 63, r16 = lane & 15, q4 = lane >> 4;
    LAS float* bu = (LAS float*)wl;
    LAS bf16_t* hb = (LAS bf16_t*)(wl + 16 * 132 * 4);
    const float* ltab = (const float*)(P.ws + OFF_S5L) + (size_t)(g * 64 + lane) * 2; const float lbr = ltab[0], lbi = ltab[1];
    const float* btab = (const float*)(P.ws + OFF_S5B) + (size_t)g * 128 * 16;
    bf16x8 bfr[8];
#pragma unroll
    for (int j = 0; j < 8; ++j) { u32x4 wv = {0u, 0u, 0u, 0u};
        if (q4 < 2) { const float* s = btab + (16 * j + r16) * 16 + 8 * q4; wv.x = pk2(s[0], s[1]); wv.y = pk2(s[2], s[3]); wv.z = pk2(s[4], s[5]); wv.w = pk2(s[6], s[7]); }
        bfr[j] = __builtin_bit_cast(bf16x8, wv); }
    bf16x8 cfr[4];
#pragma unroll
    for (int ks = 0; ks < 4; ++ks) { const int n0 = 32 * ks + 8 * q4; float v[8];
#pragma unroll
        for (int i = 0; i < 8; ++i) { const int n = n0 + i; v[i] = n < 64 ? P.in[22][(size_t)(g * 16 + r16) * 64 + n] : -P.in[23][(size_t)(g * 16 + r16) * 64 + n - 64]; }
        u32x4 wv; wv.x = pk2(v[0], v[1]); wv.y = pk2(v[2], v[3]); wv.z = pk2(v[4], v[5]); wv.w = pk2(v[6], v[7]); cfr[ks] = __builtin_bit_cast(bf16x8, wv); }
    float dsk[4];
#pragma unroll
    for (int j = 0; j < 4; ++j) dsk[j] = P.in[24][g * 16 + 4 * q4 + j];
    bf16_t* U = (bf16_t*)(P.ws + OFF_BIG) + (size_t)b * L_ * ABW + 3072 + g * 16;
    float hr = 0.f, hi = 0.f;
    if constexpr (MODE == 1) { float pr = lbr, pi = lbi;
#pragma unroll
        for (int k = 0; k < 9; ++k) { const float nr = pr * pr - pi * pi, ni = 2.f * pr * pi; pr = nr; pi = ni; }
        for (int j = 0; j < seg; ++j) { const float ar = hst[(j * 64 + lane) * 2], ai = hst[(j * 64 + lane) * 2 + 1]; const float nr = pr * hr - pi * hi + ar, ni = pr * hi + pi * hr + ai; hr = nr; hi = ni; } }
    const int c0 = seg * 8;
    u32x4 an[4]; u32x2 un[4];
#pragma unroll
    for (int s = 0; s < 4; ++s) { an[s] = (u32x4){0u, 0u, 0u, 0u}; if (q4 < 2) an[s] = *(const u32x4*)(U + (size_t)(c0 * 64 + s * 16 + r16) * ABW + 8 * q4); un[s] = *(const u32x2*)(U + (size_t)(c0 * 64 + s * 16 + r16) * ABW + 4 * q4); }
    for (int c = c0; c < c0 + 8; ++c) {
        u32x4 ac[4]; u32x2 uc[4];
#pragma unroll
        for (int s = 0; s < 4; ++s) { ac[s] = an[s]; uc[s] = un[s]; }
        if (c < c0 + 7) {
#pragma unroll
            for (int s = 0; s < 4; ++s) { const bf16_t* up = U + (size_t)((c + 1) * 64 + s * 16 + r16) * ABW; if (q4 < 2) an[s] = *(const u32x4*)(up + 8 * q4); un[s] = *(const u32x2*)(up + 4 * q4); }
        }
#pragma unroll
        for (int s = 0; s < 4; ++s) {
            const bf16x8 af = __builtin_bit_cast(bf16x8, ac[s]);
#pragma unroll
            for (int j = 0; j < 8; ++j) { f32x4 a = {0.f, 0.f, 0.f, 0.f}; a = MFMA16(af, bfr[j], a);
#pragma unroll
                for (int jj = 0; jj < 4; ++jj) bu[(4 * q4 + jj) * 132 + 16 * j + r16] = a[jj]; }
            __builtin_amdgcn_fence(__ATOMIC_RELEASE, "wavefront"); __builtin_amdgcn_wave_barrier(); __builtin_amdgcn_fence(__ATOMIC_ACQUIRE, "wavefront");
#pragma unroll
            for (int t = 0; t < 16; ++t) { const float re = bu[t * 132 + lane], im = bu[t * 132 + 64 + lane];
                const float nr = lbr * hr - lbi * hi + re, ni = lbr * hi + lbi * hr + im; hr = nr; hi = ni;
                if constexpr (MODE == 1) { hb[t * 136 + lane] = f2bf(hr); hb[t * 136 + 64 + lane] = f2bf(hi); } }
            __builtin_amdgcn_fence(__ATOMIC_RELEASE, "wavefront"); __builtin_amdgcn_wave_barrier(); __builtin_amdgcn_fence(__ATOMIC_ACQUIRE, "wavefront");
            if constexpr (MODE == 1) {
            f32x4 y = {0.f, 0.f, 0.f, 0.f};
#pragma unroll
            for (int ks = 0; ks < 4; ++ks) { const bf16x8 hf = *(const LAS bf16x8*)(hb + r16 * 136 + 32 * ks + 8 * q4); y = MFMA16(cfr[ks], hf, y); }
            const float u0 = bflo(uc[s].x), u1 = bfhi(uc[s].x), u2 = bflo(uc[s].y), u3 = bfhi(uc[s].y); u32x2 wv;
            wv.x = pk2(gelu_t(y[0] + dsk[0] * u0), gelu_t(y[1] + dsk[1] * u1)); wv.y = pk2(gelu_t(y[2] + dsk[2] * u2), gelu_t(y[3] + dsk[3] * u3));
            *(u32x2*)(U + (size_t)(c * 64 + s * 16 + r16) * ABW + 4 * q4) = wv;
            }
            __builtin_amdgcn_wave_barrier();
        }
    }
    if constexpr (MODE == 0) { hst[(seg * 64 + lane) * 2] = hr; hst[(seg * 64 + lane) * 2 + 1] = hi; }
}
constexpr size_t OFF_XB2 = OFF_PB + (size_t)T_ * 256 * 2;
static_assert(OFF_XB2 + (size_t)T_ * 1024 * 2 <= OFF_BIG + SZ_BIG, "BIG tail");
__global__ void __launch_bounds__(512, 2) mega(Params P) {
    extern __shared__ __attribute__((aligned(16))) unsigned char shm[];
    LAS unsigned char* lds = (LAS unsigned char*)shm;
    cg::grid_group grid = cg::this_grid();
    unsigned char* ws = P.ws;
    bf16_t* XB = (bf16_t*)(ws + OFF_XB); bf16_t* XB2 = (bf16_t*)(ws + OFF_XB2); bf16_t* BIG = (bf16_t*)(ws + OFF_BIG); bf16_t* PB = (bf16_t*)(ws + OFF_PB); float* PP = (float*)(ws + OFF_BIG); float* X = P.out;
    const int wave = __builtin_amdgcn_readfirstlane(otid() >> 6);
#ifndef NO_P0
    p0_phase(P, lds);
#endif
    grid.sync();
#pragma unroll 1
    for (int l = 0; l < 2; ++l) {
        const float* lng = P.in[2] + (size_t)l * 3 * D_; const float* lnb = P.in[3] + (size_t)l * 3 * D_;
        run_gemm(lds, l == 0 ? XB : XB2, D_, (const bf16_t*)(ws + OFF_WGU + (size_t)(l * 2) * SZ_WGU), 5632, D_, EpiSwiGLU{BIG}); grid.sync();
        run_gemm(lds, BIG, FF_, (const bf16_t*)(ws + OFF_WD + (size_t)(l * 2) * SZ_WD), D_, FF_, EpiRes{l == 0 ? P.in[0] : X, X, 0.5f}); grid.sync();
        ln_phase(X, XB, lng, lnb); grid.sync();
        if (l == 0) {
            run_gemm(lds, XB, D_, (const bf16_t*)(ws + OFF_WABIN), ABW, D_, EpiBf16{BIG, ABW}); grid.sync();
            {
                float* stb = (float*)(ws + OFF_XB); float* s5b = stb + (size_t)64 * 4 * (128 * 64 + 128);
                for (int it = blockIdx.x; it < 256; it += gridDim.x) {
                    { const int bb = it >> 6, hh = (it >> 2) & 15, sg = it & 3; if (sg < 3) cla_item<0, 0, 4>(P, lds, bb, hh, sg, stb + (size_t)((bb * 16 + hh) * 4) * (128 * 64 + 128)); }
                    __syncthreads();
                    { const int bb = it >> 6, gg = it & 63; if (wave < 7) s5_wave<0>(P, lds + wave * 13312, bb, gg, wave, s5b + (size_t)((bb * 64 + gg) * 8) * 128); }
                    __syncthreads();
                }
                grid.sync();
                for (int it = blockIdx.x; it < 256; it += gridDim.x) {
                    { const int bb = it >> 6, hh = (it >> 2) & 15, sg = it & 3; cla_item<0, 1, 4>(P, lds, bb, hh, sg, stb + (size_t)((bb * 16 + hh) * 4) * (128 * 64 + 128)); }
                    __syncthreads();
                    { const int bb = it >> 6, gg = it & 63; s5_wave<1>(P, lds + wave * 13312, bb, gg, wave, s5b + (size_t)((bb * 64 + gg) * 8) * 128); }
                    __syncthreads();
                }
            }
            grid.sync();
            run_gemm(lds, BIG + 3072, ABW, (const bf16_t*)(ws + OFF_WGLU), D_, D_, EpiGLU{BIG + 3072, BIG + 1024, P.in[26]});
            ssd_rms_phase(BIG, P.in[16]); grid.sync();
            run_gemm(lds, BIG, ABW, (const bf16_t*)(ws + OFF_WABOUT), D_, 2048, EpiRes{X, X, 1.0f}); grid.sync();
        } else {
            run_gemm(lds, XB, D_, (const bf16_t*)(ws + OFF_WCDIN), CDW, D_, EpiBf16{BIG, CDW}); grid.sync();
            {
                float* stb1 = (float*)(ws + OFF_XB); float* stb2 = stb1 + (size_t)16 * 8 * (128 * 128 + 128);
                for (int it = blockIdx.x; it < 256; it += gridDim.x) { const int rem = it & 127, bb = rem >> 5, hh = (rem >> 3) & 3, sg = rem & 7;
                    if (sg < 7) { if (it < 128) cla_item<1, 0, 8>(P, lds, bb, hh, sg, stb1 + (size_t)((bb * 4 + hh) * 8) * (128 * 128 + 128));
                                  else cla_item<2, 0, 8>(P, lds, bb, hh, sg, stb2 + (size_t)((bb * 4 + hh) * 8) * (64 * 128 + 128)); }
                    __syncthreads(); }
                grid.sync();
                for (int it = blockIdx.x; it < 256; it += gridDim.x) { const int rem = it & 127, bb = rem >> 5, hh = (rem >> 3) & 3, sg = rem & 7;
                    if (it < 128) cla_item<1, 1, 8>(P, lds, bb, hh, sg, stb1 + (size_t)((bb * 4 + hh) * 8) * (128 * 128 + 128));
                    else cla_item<2, 1, 8>(P, lds, bb, hh, sg, stb2 + (size_t)((bb * 4 + hh) * 8) * (64 * 128 + 128));
                    __syncthreads(); }
            }
            grid.sync();
            run_gemm(lds, BIG, CDW, (const bf16_t*)(ws + OFF_WCDOUT), D_, D_, EpiRes{X, X, 1.0f}); grid.sync();
        }
        ln_phase(X, XB, lng + D_, lnb + D_); grid.sync();
        run_gemm(lds, XB, D_, (const bf16_t*)(ws + OFF_WGU + (size_t)(l * 2 + 1) * SZ_WGU), 5632, D_, EpiSwiGLU{BIG}); grid.sync();
        run_gemm(lds, BIG, FF_, (const bf16_t*)(ws + OFF_WD + (size_t)(l * 2 + 1) * SZ_WD), D_, FF_, EpiRes{X, X, 0.5f}); grid.sync();
        ln_phase(X, XB, lng + 2 * D_, lnb + 2 * D_); p_to_bf16(P.in[1] + (size_t)l * T_ * 256, PB); grid.sync();
        run_gemm(lds, PB, 256, (const bf16_t*)(ws + OFF_WPP + (size_t)l * SZ_WPP), D_, 256, EpiF32{PP});
        run_gemm(lds, XB, D_, (const bf16_t*)(ws + OFF_WPG + (size_t)l * SZ_W1K), D_, D_, EpiPLE{X, PP, XB2});
        if (l == 0) grid.sync();
    }
}

extern "C" void kernel_launch(void* const* d_in, const int* in_sizes, int n_in, void* d_out, int out_size, void* d_ws, size_t ws_size, hipStream_t stream) {
    static int grid = 0;
    if (grid == 0) {
        if (n_in != 34 || out_size != T_ * D_ || ws_size < WS_END) { fprintf(stderr, "kernel_launch: unexpected shapes (n_in %d, out %d, ws %zu < %zu)\n", n_in, out_size, ws_size, (size_t)WS_END); grid = -1; return; }
        int dev = 0, cus = 0, per_cu = 0;
        hipGetDevice(&dev); hipDeviceGetAttribute(&cus, hipDeviceAttributeMultiprocessorCount, dev);
        if (hipFuncSetAttribute((const void*)mega, hipFuncAttributeMaxDynamicSharedMemorySize, LDS_BYTES) != hipSuccess) { fprintf(stderr, "kernel_launch: hipFuncSetAttribute failed\n"); grid = -1; return; }
        if (hipOccupancyMaxActiveBlocksPerMultiprocessor(&per_cu, (const void*)mega, 512, LDS_BYTES) != hipSuccess || per_cu < 1) { fprintf(stderr, "kernel_launch: occupancy query says %d\n", per_cu); per_cu = 1; }
        (void)hipGetLastError();
        grid = cus * per_cu;
    }
    if (grid < 0) return;
    Params P{};
    for (int i = 0; i < 34; ++i) P.in[i] = (const float*)d_in[i];
    P.out = (float*)d_out; P.ws = (unsigned char*)d_ws;
    void* args[] = {&P};
    hipError_t e = hipLaunchCooperativeKernel((const void*)mega, dim3(grid), dim3(512), args, LDS_BYTES, stream);
    if (e != hipSuccess) fprintf(stderr, "cooperative launch failed: %s (grid %d)\n", hipGetErrorString(e), grid);
}
```

```cpp
#include <hip/hip_runtime.h>
#include <hip/hip_cooperative_groups.h>
#include <cstdio>
namespace cg = cooperative_groups;
namespace pg8 {
#define PG8_LAS __attribute__((address_space(3)))
typedef unsigned short bf16_t;
typedef short bf16x8 __attribute__((ext_vector_type(8)));
typedef float f32x4 __attribute__((ext_vector_type(4)));
typedef unsigned u32x4 __attribute__((ext_vector_type(4)));
constexpr int BM = 256, BK = 64, HALF = 128, HTB = HALF * BK * 2  , STAGE_BYTES = 8 * HTB, NXCD = 8, WGM = 8;

__host__ __device__ __forceinline__ int lds_byte(int r, int c) { const int st = (r >> 4) * 2 + (c >> 5), rr = r & 15, cc = c & 31, ob = rr * 64 + cc * 2; return st * 1024 + (ob ^ (((ob >> 9) & 1) << 5)); }
__host__ __device__ __forceinline__ void stage_rc(int b, int& R, int& C) { const int st = b / 1024, sb = b % 1024, swz = sb ^ (((sb >> 9) & 1) << 5); R = (st >> 1) * 16 + swz / 64; C = (st & 1) * 32 + (swz % 64) / 2; }
__host__ __device__ __forceinline__ int perm32(int rho) { const int n = rho >> 4, i = rho & 15; return 8 * (i >> 2) + 4 * n + (i & 3); }

struct Unit { int pm, pn; };
struct Gemm { const bf16_t* A; const bf16_t* Bt; int M, N, K, lda; };

struct StaticOrder {
    int nM, nN, nwg, G, c;
    __host__ __device__ void init(int M, int N, int G_, int c_) { nM = M / BM; nN = N / BM; nwg = nM * nN; G = G_; c = c_; }
    __host__ __device__ bool next(int i, Unit& u) const {
        const long L = (long)i * G + c; if (L >= nwg) return false;
        int wgid = (int)L; { const int q = nwg / NXCD, r = nwg % NXCD, xcd = wgid % NXCD, off = wgid / NXCD; wgid = (xcd < r ? xcd * (q + 1) : r * (q + 1) + (xcd - r) * q) + off; }
        const int nig = WGM * nN, gid = wgid / nig, fm = gid * WGM, gsz = (nM - fm) < WGM ? (nM - fm) : WGM;
        u.pm = fm + ((wgid % nig) % gsz); u.pn = (wgid % nig) / gsz; return true;
    }
    __device__ __forceinline__ void a_ready(const Unit&) const {}
    __device__ __forceinline__ void done(const Unit&) const {}
};
__device__ __forceinline__ unsigned cvt_pk_bf16(float lo, float hi) { unsigned r; asm volatile("v_cvt_pk_bf16_f32 %0, %1, %2" : "=v"(r) : "v"(lo), "v"(hi)); return r; }
template <class Epi, class Sched, bool STAMP = false>
__device__ __forceinline__ void gemm_phase(PG8_LAS unsigned char* lds, const Gemm g, const Sched& S, const Epi& E, unsigned long long* stamps) {
    int tid_o = threadIdx.x; asm volatile("" : "+v"(tid_o)); const int tid = tid_o, wid = __builtin_amdgcn_readfirstlane(tid >> 6), lane = tid & 63, wr = wid >> 2, wc = wid & 3, fr = lane & 15, fq = lane >> 4;
    const int K = g.K, nt = K / BK;
    int ts_lo = 0, ts_hi = 0, nts = 0; const unsigned long long rt_entry = STAMP ? (unsigned long long)wall_clock64() : 0ull;
#define PG8_STAMP() do { if (STAMP && wid == 0 && nts < 64) { const unsigned long long _c = (unsigned long long)clock64(); \
        ts_lo = (lane == nts) ? (int)(unsigned)_c : ts_lo; ts_hi = (lane == nts) ? (int)(unsigned)(_c >> 32) : ts_hi; ++nts; } } while (0)
    PG8_STAMP();
    unsigned voffA[2], voffB[2];
#pragma unroll
    for (int i = 0; i < 2; ++i) { int R, C; stage_rc(tid * 16 + i * 8192, R, C); const int Rb = Epi::PERM ? ((R & ~31) + perm32(R & 31)) : R;
        voffA[i] = (unsigned)(R * g.lda + C) * 2u; voffB[i] = (unsigned)(Rb * K + C) * 2u; }
    const size_t kstep = (size_t)(BK * 2);
    const size_t hstepB = (size_t)HALF * K * 2, hstepA = (size_t)HALF * g.lda * 2;
    const size_t tstepA = 2 * hstepA, tstepB = 2 * hstepB;
    const unsigned ldsw = (unsigned)wid * 1024u;
    const int aoff = lds_byte(wr * 64 + fr, fq * 8), boff = lds_byte(wc * 32 + fr, fq * 8);
#define PG8_SA(b, h) (((b) * 2 + (h)) * HTB)
#define PG8_SB(b, h) ((4 + (b) * 2 + (h)) * HTB)
#define PG8_STAGE(bufoff, gbase, voff) do { _Pragma("unroll") for (int _i = 0; _i < 2; ++_i) \
        __builtin_amdgcn_global_load_lds((const unsigned*)((const char*)(gbase) + (voff)[_i]), (PG8_LAS unsigned*)(lds + (bufoff) + ldsw + _i * 8192), 16, 0, 0); } while (0)
#define PG8_LDA(dst, b, h) do { _Pragma("unroll") for (int m = 0; m < 4; ++m) _Pragma("unroll") for (int k = 0; k < 2; ++k) dst[m][k] = *(const PG8_LAS bf16x8*)(lds + PG8_SA(b, h) + aoff + m * 2048 + k * 1024); } while (0)
#define PG8_LDB(dst, b, h) do { _Pragma("unroll") for (int n = 0; n < 2; ++n) _Pragma("unroll") for (int k = 0; k < 2; ++k) dst[n][k] = *(const PG8_LAS bf16x8*)(lds + PG8_SB(b, h) + boff + n * 2048 + k * 1024); } while (0)
#define PG8_MMA(ai, bj, At, Bt) do { __builtin_amdgcn_s_setprio(1); _Pragma("unroll") for (int m = 0; m < 4; ++m) _Pragma("unroll") for (int n = 0; n < 2; ++n) _Pragma("unroll") for (int k = 0; k < 2; ++k) \
        acc[ai][bj][m][n] = __builtin_amdgcn_mfma_f32_16x16x32_bf16(Bt[n][k], At[m][k], acc[ai][bj][m][n], 0, 0, 0); __builtin_amdgcn_s_setprio(0); } while (0)
#define PG8_WAIT_V(n) asm volatile("s_waitcnt vmcnt(" #n ")" ::: "memory")
#define PG8_WAIT_L(n) asm volatile("s_waitcnt lgkmcnt(" #n ")" ::: "memory")
#define PG8_BAR __builtin_amdgcn_s_barrier()
#define PG8_SCHED __builtin_amdgcn_sched_barrier(0)
    Unit cur, nxt; int ui = 0;
    if (!S.next(0, cur)) return;
    f32x4 acc[2][2][4][2];
#pragma unroll
    for (int a = 0; a < 2; ++a)
#pragma unroll
        for (int b = 0; b < 2; ++b)
#pragma unroll
            for (int m = 0; m < 4; ++m)
#pragma unroll
                for (int n = 0; n < 2; ++n) acc[a][b][m][n] = (f32x4){0.f, 0.f, 0.f, 0.f};
    bf16x8 At[4][2], B0[2][2], B1[2][2];
    const char* cA = (const char*)g.A + (size_t)cur.pm * tstepA; const char* cB = (const char*)g.Bt + (size_t)cur.pn * tstepB;
    S.a_ready(cur);
    PG8_STAGE(PG8_SB(0, 0), cB, voffB); PG8_STAGE(PG8_SA(0, 0), cA, voffA); PG8_STAGE(PG8_SB(0, 1), cB + hstepB, voffB); PG8_STAGE(PG8_SA(0, 1), cA + hstepA, voffA);
    if (wr == 1) PG8_BAR;
    PG8_WAIT_V(4); PG8_BAR;
    PG8_STAGE(PG8_SB(1, 0), cB + kstep, voffB); PG8_STAGE(PG8_SA(1, 0), cA + kstep, voffA); PG8_STAGE(PG8_SB(1, 1), cB + hstepB + kstep, voffB);
    PG8_WAIT_V(6); PG8_BAR;
    PG8_STAMP();
    for (;;) {
        const bool has_next = S.next(ui + 1, nxt);
        const char* nA = has_next ? (const char*)g.A + (size_t)nxt.pm * tstepA : cA; const char* nB = has_next ? (const char*)g.Bt + (size_t)nxt.pn * tstepB : cB;
        for (int t = 0; t < nt; t += 2) {
            const bool last = (t == nt - 2);
            const char* a1 = cA + (size_t)(t + 1) * kstep;
            const char* a2 = last ? nA : cA + (size_t)(t + 2) * kstep; const char* b2 = last ? nB : cB + (size_t)(t + 2) * kstep;
            const char* a3 = a2 + kstep; const char* b3 = b2 + kstep;
            if (last && has_next) S.a_ready(nxt);
            PG8_LDB(B0, 0, 0); PG8_SCHED; PG8_LDA(At, 0, 0); PG8_STAGE(PG8_SA(1, 1), a1 + hstepA, voffA);
            PG8_WAIT_L(8); PG8_BAR; PG8_WAIT_L(0); PG8_MMA(0, 0, At, B0); PG8_BAR; PG8_SCHED;
            PG8_LDB(B1, 0, 1); PG8_STAGE(PG8_SB(0, 0), b2, voffB);
            PG8_BAR; PG8_WAIT_L(0); PG8_MMA(0, 1, At, B1); PG8_BAR;
            PG8_LDA(At, 0, 1); PG8_STAGE(PG8_SA(0, 0), a2, voffA);
            PG8_BAR; PG8_WAIT_L(0); PG8_MMA(1, 0, At, B0); PG8_BAR; PG8_SCHED;
            PG8_STAGE(PG8_SB(0, 1), b2 + hstepB, voffB);
            PG8_WAIT_V(6); PG8_BAR; PG8_MMA(1, 1, At, B1); PG8_BAR;
            PG8_LDB(B0, 1, 0); PG8_SCHED; PG8_LDA(At, 1, 0); PG8_STAGE(PG8_SA(0, 1), a2 + hstepA, voffA);
            PG8_WAIT_L(8); PG8_BAR; PG8_WAIT_L(0); PG8_MMA(0, 0, At, B0); PG8_BAR; PG8_SCHED;
            PG8_LDB(B1, 1, 1); PG8_STAGE(PG8_SB(1, 0), b3, voffB);
            PG8_BAR; PG8_WAIT_L(0); PG8_MMA(0, 1, At, B1); PG8_BAR;
            PG8_LDA(At, 1, 1); PG8_STAGE(PG8_SA(1, 0), a3, voffA);
            PG8_BAR; PG8_WAIT_L(0); PG8_MMA(1, 0, At, B0); PG8_BAR; PG8_SCHED;
            PG8_STAGE(PG8_SB(1, 1), b3 + hstepB, voffB);
            PG8_WAIT_V(6); PG8_BAR; PG8_MMA(1, 1, At, B1); PG8_BAR;
        }
        PG8_STAMP();
        if constexpr (!Epi::AFTER_DRAIN) { E(acc, cur, wr, wc, fr, fq); S.done(cur); }
        PG8_STAMP();
        if (!has_next) break;
#pragma unroll
        for (int a = 0; a < 2; ++a)
#pragma unroll
            for (int b = 0; b < 2; ++b)
#pragma unroll
                for (int m = 0; m < 4; ++m)
#pragma unroll
                    for (int n = 0; n < 2; ++n) acc[a][b][m][n] = (f32x4){0.f, 0.f, 0.f, 0.f};
        cur = nxt; cA = nA; cB = nB; ++ui;
    }
    PG8_WAIT_V(0);
    if (wr == 0) PG8_BAR;
    PG8_BAR;
    if constexpr (Epi::AFTER_DRAIN) { E.fused(acc, cur, wr, wc, fr, fq, lds, wid, lane); S.done(cur); }
    PG8_STAMP();
    if (STAMP && wid == 0) { stamps[lane] = lane < nts ? (((unsigned long long)(unsigned)ts_hi << 32) | (unsigned)ts_lo) : 0ull;
        if (lane == 62) stamps[62] = rt_entry; if (lane == 63) stamps[63] = (unsigned long long)wall_clock64(); }
#undef PG8_STAMP
#undef PG8_SA
#undef PG8_SB
#undef PG8_STAGE
#undef PG8_LDA
#undef PG8_LDB
#undef PG8_MMA
#undef PG8_WAIT_V
#undef PG8_WAIT_L
#undef PG8_BAR
#undef PG8_SCHED
}
}
#define LAS __attribute__((address_space(3)))
#define DI __device__ __forceinline__
using pg8::bf16_t; using pg8::bf16x8; using pg8::f32x4; using pg8::u32x4;
typedef unsigned u32x2 __attribute__((ext_vector_type(2)));

constexpr int T_ = 16384, D_ = 1024, FF_ = 2816, L_ = 4096;
constexpr int ABW = 4352, CDW = 3840;
constexpr float DN_ALPHA = 1.41421356237f, EPS_ = 1e-5f;
constexpr int LDS_BYTES = 144 * 1024;

constexpr size_t SZ_WGU = (size_t)5632 * 1024 * 2, SZ_WD = (size_t)1024 * 2816 * 2, SZ_W1K = (size_t)1024 * 1024 * 2, SZ_WPP = (size_t)1024 * 256 * 2;
constexpr size_t OFF_WGU = 0;
constexpr size_t OFF_WD = OFF_WGU + 4 * SZ_WGU;
constexpr size_t OFF_WPG = OFF_WD + 4 * SZ_WD;
constexpr size_t OFF_WPP = OFF_WPG + 2 * SZ_W1K;
constexpr size_t OFF_WABIN = OFF_WPP + 2 * SZ_WPP;
constexpr size_t OFF_WABOUT = OFF_WABIN + (size_t)ABW * 1024 * 2;
constexpr size_t OFF_WGLU = OFF_WABOUT + (size_t)1024 * 2048 * 2;
constexpr size_t OFF_WCDIN = OFF_WGLU + SZ_W1K;
constexpr size_t OFF_WCDOUT = OFF_WCDIN + (size_t)CDW * 1024 * 2;
constexpr size_t OFF_XB = OFF_WCDOUT + SZ_W1K;
constexpr size_t OFF_BIG = OFF_XB + (size_t)T_ * 1024 * 2;
constexpr size_t SZ_BIG = (size_t)T_ * ABW * 2;
constexpr size_t OFF_PB = OFF_BIG + (size_t)T_ * FF_ * 2;
constexpr size_t OFF_S5L = OFF_BIG + SZ_BIG;
constexpr size_t OFF_S5B = OFF_S5L + 64 * 64 * 2 * 4;
constexpr size_t WS_END = OFF_S5B + (size_t)64 * 128 * 16 * 4;

DI int otid() { int t = threadIdx.x; asm volatile("" : "+v"(t)); return t; }
struct Params { const float* in[34]; float* out; unsigned char* ws; };

DI unsigned pk2(float lo, float hi) { unsigned r; asm("v_cvt_pk_bf16_f32 %0, %1, %2" : "=v"(r) : "v"(lo), "v"(hi)); return r; }
DI float bflo(unsigned w) { return __uint_as_float(w << 16); }
DI float bfhi(unsigned w) { return __uint_as_float(w & 0xffff0000u); }
DI float bf2f(bf16_t b) { return __uint_as_float(((unsigned)b) << 16); }
DI bf16_t f2bf(float f) { return (bf16_t)(pk2(f, 0.f) & 0xffffu); }
DI float sigm(float x) { return 1.f / (1.f + __expf(-x)); }
DI float silu(float x) { return x / (1.f + __expf(-x)); }
DI float softplus(float x) { return x > 20.f ? x : log1pf(__expf(x)); }
DI float logsigm(float x) { return fminf(x, 0.f) - log1pf(__expf(-fabsf(x))); }
DI float gelu_t(float x) { const float u = 0.7978845608f * (x + 0.044715f * x * x * x); return x / (1.f + __expf(-2.f * u)); }

typedef const f32x4 (&AccT)[2][2][4][2];
struct EpiSwiGLU { static constexpr bool PERM = false, AFTER_DRAIN = false; bf16_t* H;
    DI void operator()(AccT acc, const pg8::Unit& u, int wr, int wc, int fr, int fq) const {
        const int row0 = u.pm * 256 + wr * 64 + fr, col0 = u.pn * 128 + wc * 32 + 4 * fq;
#pragma unroll
        for (int ai = 0; ai < 2; ++ai)
#pragma unroll
            for (int m = 0; m < 4; ++m) { bf16_t* rowp = H + (size_t)(row0 + ai * 128 + m * 16) * FF_ + col0;
#pragma unroll
                for (int n = 0; n < 2; ++n) { const f32x4 g = acc[ai][0][m][n], v = acc[ai][1][m][n]; u32x2 w;
                    w.x = pk2(silu(g[0]) * v[0], silu(g[1]) * v[1]); w.y = pk2(silu(g[2]) * v[2], silu(g[3]) * v[3]); *(u32x2*)(rowp + n * 16) = w; } }
    } };
struct EpiRes { static constexpr bool PERM = false, AFTER_DRAIN = false; const float* base; float* out; float scale;
    DI void operator()(AccT acc, const pg8::Unit& u, int wr, int wc, int fr, int fq) const {
        const int row0 = u.pm * 256 + wr * 64 + fr, col0 = u.pn * 256 + wc * 32 + 4 * fq;
#pragma unroll
        for (int ai = 0; ai < 2; ++ai)
#pragma unroll
            for (int m = 0; m < 4; ++m) { const size_t off = (size_t)(row0 + ai * 128 + m * 16) * D_ + col0;
#pragma unroll
                for (int bj = 0; bj < 2; ++bj)
#pragma unroll
                    for (int n = 0; n < 2; ++n) { const size_t o = off + bj * 128 + n * 16; const f32x4 b = *(const f32x4*)(base + o); *(f32x4*)(out + o) = b * DN_ALPHA + acc[ai][bj][m][n] * scale; } }
    } };
struct EpiBf16 { static constexpr bool PERM = false, AFTER_DRAIN = false; bf16_t* O; int ldc;
    DI void operator()(AccT acc, const pg8::Unit& u, int wr, int wc, int fr, int fq) const {
        const int row0 = u.pm * 256 + wr * 64 + fr, col0 = u.pn * 256 + wc * 32 + 4 * fq;
#pragma unroll
        for (int ai = 0; ai < 2; ++ai)
#pragma unroll
            for (int m = 0; m < 4; ++m) { bf16_t* rowp = O + (size_t)(row0 + ai * 128 + m * 16) * ldc + col0;
#pragma unroll
                for (int bj = 0; bj < 2; ++bj)
#pragma unroll
                    for (int n = 0; n < 2; ++n) { const f32x4 v = acc[ai][bj][m][n]; u32x2 w; w.x = pk2(v[0], v[1]); w.y = pk2(v[2], v[3]); *(u32x2*)(rowp + bj * 128 + n * 16) = w; } }
    } };
struct EpiGLU { static constexpr bool PERM = false, AFTER_DRAIN = false; const bf16_t* G; bf16_t* Y; const float* bias;
    DI void operator()(AccT acc, const pg8::Unit& u, int wr, int wc, int fr, int fq) const {
        const int row0 = u.pm * 256 + wr * 64 + fr, col0 = u.pn * 256 + wc * 32 + 4 * fq;
#pragma unroll
        for (int ai = 0; ai < 2; ++ai)
#pragma unroll
            for (int m = 0; m < 4; ++m) { const size_t off = (size_t)(row0 + ai * 128 + m * 16) * ABW + col0;
#pragma unroll
                for (int bj = 0; bj < 2; ++bj)
#pragma unroll
                    for (int n = 0; n < 2; ++n) { const int cc = bj * 128 + n * 16; const f32x4 v = acc[ai][bj][m][n]; const f32x4 bv = *(const f32x4*)(bias + col0 + cc);
                        const u32x2 g = *(const u32x2*)(G + off + cc); u32x2 w;
                        w.x = pk2(bflo(g.x) * sigm(v[0] + bv[0]), bfhi(g.x) * sigm(v[1] + bv[1])); w.y = pk2(bflo(g.y) * sigm(v[2] + bv[2]), bfhi(g.y) * sigm(v[3] + bv[3]));
                        *(u32x2*)(Y + off + cc) = w; } }
    } };
struct EpiF32 { static constexpr bool PERM = false, AFTER_DRAIN = false; float* C;
    DI void operator()(AccT acc, const pg8::Unit& u, int wr, int wc, int fr, int fq) const {
        const int row0 = u.pm * 256 + wr * 64 + fr, col0 = u.pn * 256 + wc * 32 + 4 * fq;
#pragma unroll
        for (int ai = 0; ai < 2; ++ai)
#pragma unroll
            for (int m = 0; m < 4; ++m) { const size_t off = (size_t)(row0 + ai * 128 + m * 16) * D_ + col0;
#pragma unroll
                for (int bj = 0; bj < 2; ++bj)
#pragma unroll
                    for (int n = 0; n < 2; ++n) *(f32x4*)(C + off + bj * 128 + n * 16) = acc[ai][bj][m][n]; }
    } };
struct EpiPLE { static constexpr bool PERM = false, AFTER_DRAIN = false; float* X; const float* PP; bf16_t* XB;
    DI void operator()(AccT acc, const pg8::Unit& u, int wr, int wc, int fr, int fq) const {
        const int row0 = u.pm * 256 + wr * 64 + fr, col0 = u.pn * 256 + wc * 32 + 4 * fq;
#pragma unroll
        for (int ai = 0; ai < 2; ++ai)
#pragma unroll
            for (int m = 0; m < 4; ++m) { const size_t off = (size_t)(row0 + ai * 128 + m * 16) * D_ + col0;
#pragma unroll
                for (int bj = 0; bj < 2; ++bj)
#pragma unroll
                    for (int n = 0; n < 2; ++n) { const size_t o = off + bj * 128 + n * 16; const f32x4 a = acc[ai][bj][m][n]; const f32x4 x = *(const f32x4*)(X + o), pp = *(const f32x4*)(PP + o); f32x4 r;
#pragma unroll
                        for (int j = 0; j < 4; ++j) r[j] = x[j] + sigm(a[j]) * pp[j];
                        *(f32x4*)(X + o) = r; u32x2 w; w.x = pk2(r[0], r[1]); w.y = pk2(r[2], r[3]); *(u32x2*)(XB + o) = w; } }
    } };

template <class Epi> DI void run_gemm(LAS unsigned char* lds, const bf16_t* A, int lda, const bf16_t* Bt, int N, int K, const Epi& E) {
    pg8::Gemm g{A, Bt, T_, N, K, lda}; pg8::StaticOrder S; S.init(T_, N, (int)gridDim.x, (int)blockIdx.x);
    pg8::gemm_phase<Epi, pg8::StaticOrder, false>(lds, g, S, E, nullptr);
}
#define XB_TMO      128
#define XB_XCNT(j)  (256  + 64 * (j))
#define XB_XSUB(j)  (1280 + 64 * (j))
#define XB_XGEN(j)  (2304 + 64 * (j))
#define XB_TOP      3328
#define XB_TOPGEN   3392
#define XCD_BAR_WORDS 3456
#define XB_SPIN_CAP (1u << 18)

__device__ __forceinline__ unsigned xb_ld(unsigned* p)              { return __hip_atomic_load(p, __ATOMIC_RELAXED, __HIP_MEMORY_SCOPE_AGENT); }
__device__ __forceinline__ unsigned xb_add(unsigned* p, unsigned v) { return __hip_atomic_fetch_add(p, v, __ATOMIC_RELAXED, __HIP_MEMORY_SCOPE_AGENT); }
__device__ __forceinline__ unsigned xb_xcc_id() { return (unsigned)__builtin_amdgcn_s_getreg((3 << 11) | 20) & 0xFu; }
#define XB_SPIN(cond, bar) do { unsigned _sp = 0; while (cond) { __builtin_amdgcn_s_sleep(1); \
    if ((++_sp & 255u) == 0u) { if (xb_ld(&(bar)[XB_TMO])) break; if (_sp > XB_SPIN_CAP) { atomicAdd(&(bar)[XB_TMO], 1u); break; } } } } while (0)

struct XcdBarrier {
    unsigned* bar; unsigned x;
    volatile LAS unsigned* st;
};

__device__ __forceinline__ XcdBarrier xcd_barrier_post(unsigned* bar, volatile LAS unsigned* st) {
    XcdBarrier b; b.bar = bar; b.x = xb_xcc_id(); b.st = st;
    if (threadIdx.x == 0) (void)xb_add(&bar[XB_XCNT(b.x)], 1u);
    return b;
}
__device__ __forceinline__ void xcd_barrier_complete(unsigned* bar, unsigned x, unsigned& nloc, unsigned& nx) {
    const unsigned G = gridDim.x * gridDim.y * gridDim.z;
    unsigned sum, cnt, mine, sp = 0u;
    for (;;) {
        sum = 0u; cnt = 0u; mine = 0u;
#pragma unroll
        for (unsigned j = 0; j < 16; ++j) { const unsigned c = xb_ld(&bar[XB_XCNT(j)]); sum += c; cnt += (c > 0u) ? 1u : 0u; mine = (j == x) ? c : mine; }
        if (sum == G) break;
        __builtin_amdgcn_s_sleep(1);
        if ((++sp & 255u) == 0u) { if (xb_ld(&bar[XB_TMO])) break; if (sp > XB_SPIN_CAP) { atomicAdd(&bar[XB_TMO], 1u); break; } }
    }
    nloc = mine > 0u ? mine : 1u; nx = cnt > 0u ? cnt : 1u;
}

__device__ __forceinline__ void xcd_barrier(const XcdBarrier& b) {
    asm volatile("s_waitcnt vmcnt(0)" ::: "memory");
    __syncthreads();
    if (threadIdx.x == 0) {
        unsigned* bar = b.bar;
        __builtin_amdgcn_s_waitcnt(0);
        unsigned nloc = b.st[0], nx = b.st[1];
        if (nloc == 0u) { xcd_barrier_complete(bar, b.x, nloc, nx); b.st[0] = nloc; b.st[1] = nx; }
        const unsigned old = xb_add(&bar[XB_XSUB(b.x)], 1u);
        const unsigned gen = old / nloc;
        if (old + 1u == (gen + 1u) * nloc) {
            __builtin_amdgcn_fence(__ATOMIC_RELEASE, "agent");
            asm volatile("s_waitcnt vmcnt(0)" ::: "memory");
            const unsigned og = xb_add(&bar[XB_TOP], 1u);
            const unsigned tg = og / nx;
            if (og + 1u == (tg + 1u) * nx) xb_add(&bar[XB_TOPGEN], 1u);
            else XB_SPIN(xb_ld(&bar[XB_TOPGEN]) == tg, bar);
            __builtin_amdgcn_fence(__ATOMIC_ACQUIRE, "agent");
            xb_add(&bar[XB_XGEN(b.x)], 1u);
            asm volatile("s_waitcnt vmcnt(0)" ::: "memory");
        } else {
            XB_SPIN(xb_ld(&bar[XB_XGEN(b.x)]) == gen, bar);
            __builtin_amdgcn_fence(__ATOMIC_ACQUIRE, "agent");
            asm volatile("s_waitcnt vmcnt(0)" ::: "memory");
        }
    }
    __syncthreads();
}
struct Job { const float* src; bf16_t* dst; int K, N, map; };
DI int mapn(int map, int n) {
    if (map == 0) return n;
    if (map == 1) return 256 * (n >> 7) + (n & 127);
    if (map == 2) return 256 * (n >> 7) + 128 + (n & 127);
    if (map == 3) return n < 3072 ? n : (n < 3088 ? n + 1024 : n - 16);
    return n < 1536 ? n + 1024 : (n < 2048 ? n - 1536 : (n < 3088 ? n + 512 : n - 2576));
}
DI Job get_job(const Params& P, int j) {
    unsigned char* ws = P.ws; Job J;
    if (j < 4)       { J.src = P.in[4] + (size_t)j * 1024 * 2816;        J.dst = (bf16_t*)(ws + OFF_WGU + j * SZ_WGU);        J.K = 1024; J.N = 2816; J.map = 1; }
    else if (j < 8)  { J.src = P.in[5] + (size_t)(j - 4) * 1024 * 2816;  J.dst = (bf16_t*)(ws + OFF_WGU + (j - 4) * SZ_WGU);  J.K = 1024; J.N = 2816; J.map = 2; }
    else if (j < 12) { J.src = P.in[6] + (size_t)(j - 8) * 2816 * 1024;  J.dst = (bf16_t*)(ws + OFF_WD + (j - 8) * SZ_WD);    J.K = 2816; J.N = 1024; J.map = 0; }
    else if (j < 14) { J.src = P.in[7] + (size_t)(j - 12) * 1024 * 1024; J.dst = (bf16_t*)(ws + OFF_WPG + (j - 12) * SZ_W1K); J.K = 1024; J.N = 1024; J.map = 0; }
    else if (j < 16) { J.src = P.in[8] + (size_t)(j - 14) * 256 * 1024;  J.dst = (bf16_t*)(ws + OFF_WPP + (j - 14) * SZ_WPP); J.K = 256;  J.N = 1024; J.map = 0; }
    else if (j == 16) { J.src = P.in[9];  J.dst = (bf16_t*)(ws + OFF_WABIN);  J.K = 1024; J.N = 4112; J.map = 3; }
    else if (j == 17) { J.src = P.in[10]; J.dst = (bf16_t*)(ws + OFF_WABOUT); J.K = 2048; J.N = 1024; J.map = 0; }
    else if (j == 18) { J.src = P.in[25]; J.dst = (bf16_t*)(ws + OFF_WGLU);   J.K = 1024; J.N = 1024; J.map = 0; }
    else if (j == 19) { J.src = P.in[27]; J.dst = (bf16_t*)(ws + OFF_WCDIN);  J.K = 1024; J.N = 3600; J.map = 4; }
    else              { J.src = P.in[28]; J.dst = (bf16_t*)(ws + OFF_WCDOUT); J.K = 1024; J.N = 1024; J.map = 0; }
    return J;
}
DI void convT_tile(LAS bf16_t* tl, const Job& J, int tile) {
    const int ntn = (J.N + 63) >> 6, tk = tile / ntn, tn = tile - tk * ntn, k0 = tk * 64, n0 = tn * 64, tid = otid();
    const int n4 = (tid & 15) * 4, kr = tid >> 4;
    if (n0 + n4 < J.N) {
#pragma unroll
        for (int ps = 0; ps < 2; ++ps) { const int k = kr + 32 * ps; const f32x4 v = *(const f32x4*)(J.src + (size_t)(k0 + k) * J.N + n0 + n4);
#pragma unroll
            for (int i = 0; i < 4; ++i) tl[(n4 + i) * 72 + k] = f2bf(v[i]); }
    }
    __syncthreads();
    const int n = tid >> 3, kg = tid & 7;
    if (n0 + n < J.N) { const u32x4 w = *(const LAS u32x4*)(tl + n * 72 + kg * 8); *(u32x4*)(J.dst + (size_t)mapn(J.map, n0 + n) * J.K + k0 + kg * 8) = w; }
    __syncthreads();
}
DI void sincos_d(double x, double& s, double& c) {
    const double kq = rint(x * 0.63661977236758134308); const double r = x - kq * 1.57079632679489661923; const double r2 = r * r;
    const double sr = r * (1.0 - r2 / 6.0 * (1.0 - r2 / 20.0 * (1.0 - r2 / 42.0 * (1.0 - r2 / 72.0 * (1.0 - r2 / 110.0 * (1.0 - r2 / 156.0 * (1.0 - r2 / 210.0)))))));
    const double cr = 1.0 - r2 / 2.0 * (1.0 - r2 / 12.0 * (1.0 - r2 / 30.0 * (1.0 - r2 / 56.0 * (1.0 - r2 / 90.0 * (1.0 - r2 / 132.0 * (1.0 - r2 / 182.0 * (1.0 - r2 / 240.0)))))));
    const int qd = ((int)kq) & 3;
    s = qd == 0 ? sr : (qd == 1 ? cr : (qd == 2 ? -sr : -cr)); c = qd == 0 ? cr : (qd == 1 ? -sr : (qd == 2 ? -cr : sr));
}
DI double exp_d(double x) { const double y = x * 0.015625; double e = 1.0 + y * (1.0 + y / 2.0 * (1.0 + y / 3.0 * (1.0 + y / 4.0 * (1.0 + y / 5.0 * (1.0 + y / 6.0 * (1.0 + y / 7.0 * (1.0 + y / 8.0 * (1.0 + y / 9.0 * (1.0 + y / 10.0))))))))); e *= e; e *= e; e *= e; e *= e; e *= e; e *= e; return e; }
DI void p0_phase(const Params& P, LAS unsigned char* lds) {
    const int tid = otid(), G = gridDim.x, bid = blockIdx.x;
    {
        int base = 0;
        for (int j = 0; j < 21; ++j) { const Job J = get_job(P, j); const int nt = (J.K >> 6) * ((J.N + 63) >> 6);
            int first = (bid - base % G + G) % G;
            for (int t = first; t < nt; t += G) convT_tile((LAS bf16_t*)lds, J, t);
            base += nt; }
    }
    const size_t gt = (size_t)bid * 512 + tid, gs = (size_t)G * 512;
    { u32x4 z = {0u, 0u, 0u, 0u}; u32x4* a = (u32x4*)(P.ws + OFF_WABIN + (size_t)4112 * 1024 * 2); for (size_t i = gt; i < (size_t)240 * 1024 * 2 / 16; i += gs) a[i] = z;
      u32x4* c = (u32x4*)(P.ws + OFF_WCDIN + (size_t)3600 * 1024 * 2); for (size_t i = gt; i < (size_t)240 * 1024 * 2 / 16; i += gs) c[i] = z; }
    { const f32x4* x = (const f32x4*)P.in[0]; u32x2* xb = (u32x2*)(P.ws + OFF_XB); for (size_t i = gt; i < (size_t)T_ * D_ / 4; i += gs) { const f32x4 v = x[i]; u32x2 w; w.x = pk2(v[0], v[1]); w.y = pk2(v[2], v[3]); xb[i] = w; } }
    for (size_t i = gt; i < 64 * 64; i += gs) { const int g = (int)(i >> 6), n = (int)(i & 63);
        const double dt = exp_d((double)P.in[19][g]);
        const double lr = (double)P.in[17][i], li = (double)P.in[18][i];
        const double e = exp_d(lr * dt); double sn, cs; sincos_d(li * dt, sn, cs); const double lbr = e * cs, lbi = e * sn;
        const double den = lr * lr + li * li, cr = ((lbr - 1.0) * lr + lbi * li) / den, ci = (lbi * lr - (lbr - 1.0) * li) / den;
        float* lt = (float*)(P.ws + OFF_S5L); lt[i * 2] = (float)lbr; lt[i * 2 + 1] = (float)lbi;
        float* bt = (float*)(P.ws + OFF_S5B) + (size_t)g * 128 * 16;
        for (int q = 0; q < 16; ++q) { const double br = (double)P.in[20][i * 16 + q], bi = (double)P.in[21][i * 16 + q]; bt[n * 16 + q] = (float)(cr * br - ci * bi); bt[(64 + n) * 16 + q] = (float)(cr * bi + ci * br); } }
}
DI float wave_sum(float v) { v += __shfl_xor(v, 32); v += __shfl_xor(v, 16); v += __shfl_xor(v, 8); v += __shfl_xor(v, 4); v += __shfl_xor(v, 2); v += __shfl_xor(v, 1); return v; }
DI void ln_phase(float* X, bf16_t* XB, const float* g, const float* b) {
    const int wave = otid() >> 6, lane = otid() & 63;
    for (int row = blockIdx.x * 8 + wave; row < T_; row += gridDim.x * 8) {
        float* r = X + (size_t)row * D_; f32x4 v[4]; float s = 0.f;
#pragma unroll
        for (int i = 0; i < 4; ++i) { v[i] = *(const f32x4*)(r + i * 256 + lane * 4); s += (v[i][0] + v[i][1]) + (v[i][2] + v[i][3]); }
        const float mean = wave_sum(s) * (1.f / 1024.f); float q = 0.f;
#pragma unroll
        for (int i = 0; i < 4; ++i) { v[i] = v[i] - mean; q += (v[i][0] * v[i][0] + v[i][1] * v[i][1]) + (v[i][2] * v[i][2] + v[i][3] * v[i][3]); }
        const float rstd = 1.0f / sqrtf(wave_sum(q) * (1.f / 1024.f) + EPS_);
#pragma unroll
        for (int i = 0; i < 4; ++i) { const f32x4 gg = *(const f32x4*)(g + i * 256 + lane * 4), bb = *(const f32x4*)(b + i * 256 + lane * 4); const f32x4 o = v[i] * rstd * gg + bb;
            *(f32x4*)(r + i * 256 + lane * 4) = o; u32x2 w; w.x = pk2(o[0], o[1]); w.y = pk2(o[2], o[3]); *(u32x2*)(XB + (size_t)row * D_ + i * 256 + lane * 4) = w; }
    }
}
DI void p_to_bf16(const float* p, bf16_t* pb) {
    const size_t gt = (size_t)blockIdx.x * 512 + otid(), gs = (size_t)gridDim.x * 512;
    for (size_t i = gt; i < (size_t)T_ * 256 / 4; i += gs) { const f32x4 v = ((const f32x4*)p)[i]; u32x2 w; w.x = pk2(v[0], v[1]); w.y = pk2(v[2], v[3]); ((u32x2*)pb)[i] = w; }
}
DI void ssd_rms_phase(bf16_t* BIG, const float* nw) {
    const int wave = otid() >> 6, lane = otid() & 63;
    for (int row = blockIdx.x * 8 + wave; row < T_; row += gridDim.x * 8) {
        bf16_t* r = BIG + (size_t)row * ABW + lane * 16; const u32x4 a = *(const u32x4*)r, c = *(const u32x4*)(r + 8);
        float v[16]; v[0] = bflo(a.x); v[1] = bfhi(a.x); v[2] = bflo(a.y); v[3] = bfhi(a.y); v[4] = bflo(a.z); v[5] = bfhi(a.z); v[6] = bflo(a.w); v[7] = bfhi(a.w);
        v[8] = bflo(c.x); v[9] = bfhi(c.x); v[10] = bflo(c.y); v[11] = bfhi(c.y); v[12] = bflo(c.z); v[13] = bfhi(c.z); v[14] = bflo(c.w); v[15] = bfhi(c.w);
        float s = 0.f;
#pragma unroll
        for (int i = 0; i < 16; ++i) s += v[i] * v[i];
        s += __shfl_xor(s, 8); s += __shfl_xor(s, 4); s += __shfl_xor(s, 2); s += __shfl_xor(s, 1);
        const float rstd = 1.0f / sqrtf(s * (1.f / 256.f) + EPS_);
        const float* w = nw + lane * 16; u32x4 o0, o1;
        o0.x = pk2(v[0] * rstd * w[0], v[1] * rstd * w[1]); o0.y = pk2(v[2] * rstd * w[2], v[3] * rstd * w[3]); o0.z = pk2(v[4] * rstd * w[4], v[5] * rstd * w[5]); o0.w = pk2(v[6] * rstd * w[6], v[7] * rstd * w[7]);
        o1.x = pk2(v[8] * rstd * w[8], v[9] * rstd * w[9]); o1.y = pk2(v[10] * rstd * w[10], v[11] * rstd * w[11]); o1.z = pk2(v[12] * rstd * w[12], v[13] * rstd * w[13]); o1.w = pk2(v[14] * rstd * w[14], v[15] * rstd * w[15]);
        *(u32x4*)r = o0; *(u32x4*)(r + 8) = o1;
    }
}
template <int KIND> struct Cfg;
template <> struct Cfg<0> { static constexpr int DK = 128, DV = 64, LD = ABW; };
template <> struct Cfg<1> { static constexpr int DK = 128, DV = 128, LD = CDW; };
template <> struct Cfg<2> { static constexpr int DK = 64, DV = 128, LD = CDW; };
#define MFMA16(a, b, c) __builtin_amdgcn_mfma_f32_16x16x32_bf16((a), (b), (c), 0, 0, 0)
#define FRAG(off, row, pitch) (*(const LAS bf16x8*)(lds + (off) + (row) * (pitch) + kb0))
#define ST16(off, val) (*(LAS bf16_t*)(lds + (off)) = (val))

template <int KIND, int MODE, int NS>
DI void cla_item(const Params& P, LAS unsigned char* lds, const int b, const int h, const int seg, float* stbase) {
    constexpr int DK = Cfg<KIND>::DK, DV = Cfg<KIND>::DV, LD = Cfg<KIND>::LD;
    constexpr int PQB = (DK + 8) * 2, P64B = 144;
    constexpr int oQs = 0, oKs = oQs + 64 * PQB, oKh = oKs + 64 * PQB, oVt = oKh + DK * P64B, oST = oVt + DV * P64B, oAt = oST + DV * PQB, oXs = oAt + 64 * P64B,
                  oTot = oXs + 64 * P64B, oEgm = oTot + 8 * 128 * 4, oEgl = oEgm + 512, oAc = oEgl + 512, oRed = oAc + 256;
    static_assert(oRed + 512 <= LDS_BYTES, "cla LDS");
    constexpr int NDT = DK / 16, WPD = 8 / NDT, NVT = DV / 16, NT = NVT / WPD, NVW = DV / 32, KS = DK / 32;
    const int tid = otid(), lane = tid & 63, w = __builtin_amdgcn_readfirstlane(tid >> 6), r16 = lane & 15, q4 = lane >> 4;
    const int lt = w >> 1, wh = w & 1, dti = w / WPD, vt0 = (w % WPD) * NT;
    bf16_t* BIG = (bf16_t*)(P.ws + OFF_BIG) + (size_t)b * L_ * LD;
    LAS float* tot = (LAS float*)(lds + oTot); LAS float* egm = (LAS float*)(lds + oEgm); LAS float* egl = (LAS float*)(lds + oEgl);
    LAS float* acum = (LAS float*)(lds + oAc); LAS float* red = (LAS float*)(lds + oRed);
    f32x4 accS[NT];
#pragma unroll
    for (int i = 0; i < NT; ++i) accS[i] = (f32x4){0.f, 0.f, 0.f, 0.f};
    constexpr int REC = DK * DV + 128;
    float gsum = 0.f;
    if constexpr (MODE == 1) {
        for (int j = 0; j < seg; ++j) { const float* rec = stbase + (size_t)j * REC; const int d0 = 16 * dti + 4 * q4;
            f32x4 e; if constexpr (KIND == 0) { const float e0 = __expf(rec[DK * DV]); e = (f32x4){e0, e0, e0, e0}; } else { const f32x4 gs = *(const f32x4*)(rec + DK * DV + d0); e = (f32x4){__expf(gs[0]), __expf(gs[1]), __expf(gs[2]), __expf(gs[3])}; }
#pragma unroll
            for (int i = 0; i < NT; ++i) accS[i] = accS[i] * e + *(const f32x4*)(rec + ((size_t)(w * NT + i) * 64 + lane) * 4); }
    }
    float c_lb = 0.f, c_bg = 0.f, c_Ah = 0.f, c_dtb = 0.f, c_Dh = 0.f; float wup[16];
#pragma unroll
    for (int r = 0; r < 16; ++r) wup[r] = 0.f;
    if constexpr (KIND == 0) { c_Ah = -__expf(P.in[14][h]); c_dtb = P.in[13][h]; c_Dh = P.in[15][h]; }
    if constexpr (KIND == 1) { const int d = tid & 127; c_lb = sigm(P.in[29][512 + h * 128 + d] - P.in[29][h * 128 + d]); }
    if constexpr (KIND == 2) { const int d = tid & 63; c_bg = P.in[32][h * 64 + d];
#pragma unroll
        for (int r = 0; r < 16; ++r) wup[r] = P.in[31][r * 256 + h * 64 + d]; }

    constexpr int CPS = 64 / NS;
    for (int c = seg * CPS; c < (seg + 1) * CPS; ++c) {
        const int t0 = c * 64;
        float eglS = 1.f;
        if constexpr (KIND == 0) {
            const int g = h >> 2; const float* cw = P.in[11]; const float* cb = P.in[12];
            const int ch = tid & 127, tg = tid >> 7, ts = t0 + tg * 16;
            float breg[16];
#pragma unroll
            for (int which = 0; which < 2; ++which) {
                const int col = (which ? 2560 : 2048) + g * 128 + ch, cc = (which ? 1536 : 1024) + g * 128 + ch;
                const float w0 = cw[cc], w1 = cw[2048 + cc], w2 = cw[4096 + cc], w3 = cw[6144 + cc], bb = cb[cc];
                const bf16_t* src = BIG + (size_t)ts * LD + col;
                float x0 = 0.f, x1 = 0.f, x2 = 0.f;
                if (ts > 0) { x0 = bf2f(src[-3 * LD]); x1 = bf2f(src[-2 * LD]); x2 = bf2f(src[-LD]); }
#pragma unroll
                for (int i = 0; i < 16; ++i) { const float x3 = bf2f(src[i * LD]); const float v = silu(w0 * x0 + w1 * x1 + w2 * x2 + w3 * x3 + bb); x0 = x1; x1 = x2; x2 = x3;
                    if (which) ST16(oQs + (tg * 16 + i) * PQB + ch * 2, f2bf(v)); else { ST16(oKs + (tg * 16 + i) * PQB + ch * 2, f2bf(v)); breg[i] = v; } }
            }
            {
                const int p = tid & 63, tg2 = tid >> 6, ts2 = t0 + tg2 * 8, cc = h * 64 + p;
                const float w0 = cw[cc], w1 = cw[2048 + cc], w2 = cw[4096 + cc], w3 = cw[6144 + cc], bb = cb[cc];
                const bf16_t* src = BIG + (size_t)ts2 * LD + 1024 + cc; const bf16_t* dsrc = BIG + (size_t)ts2 * LD + 4096 + h;
                float x0 = 0.f, x1 = 0.f, x2 = 0.f;
                if (ts2 > 0) { x0 = bf2f(src[-3 * LD]); x1 = bf2f(src[-2 * LD]); x2 = bf2f(src[-LD]); }
#pragma unroll
                for (int i = 0; i < 8; ++i) { const float x3 = bf2f(src[i * LD]); const float v = silu(w0 * x0 + w1 * x1 + w2 * x2 + w3 * x3 + bb); x0 = x1; x1 = x2; x2 = x3;
                    const float dtv = softplus(bf2f(dsrc[i * LD]) + c_dtb);
                    ST16(oVt + p * P64B + (tg2 * 8 + i) * 2, f2bf(v * dtv)); ST16(oXs + (tg2 * 8 + i) * P64B + p * 2, f2bf(v)); }
            }
            if (w == 0) { float a = softplus(bf2f(BIG[(size_t)(t0 + lane) * LD + 4096 + h]) + c_dtb) * c_Ah;
#pragma unroll
                for (int o = 1; o < 64; o <<= 1) { const float t = __shfl_up(a, o); if (lane >= o) a += t; }
                acum[lane] = a; }
            __syncthreads();
            const float alast = acum[63]; eglS = __expf(alast); gsum += alast;
#pragma unroll
            for (int i = 0; i < 16; ++i) ST16(oKh + ch * P64B + (tg * 16 + i) * 2, f2bf(breg[i] * __expf(alast - acum[tg * 16 + i])));
            __syncthreads();
        }
        if constexpr (KIND == 1) {
            const int d = tid & 127, tg = tid >> 7, ts = t0 + tg * 16;
            float qv[16], kv[16], cv[16]; float cum = 0.f;
            const bf16_t* src = BIG + (size_t)ts * LD + h * 128 + d;
#pragma unroll
            for (int i = 0; i < 16; ++i) { const float qr = bf2f(src[i * LD + 1024]), fl = bf2f(src[i * LD + 1536]); const bf16_t vr = src[i * LD + 2048];
                const float kk = (1.f - c_lb) * sigm(-fl); cum += __logf(1.f - kk); qv[i] = silu(qr); kv[i] = kk; cv[i] = cum; ST16(oVt + d * P64B + (tg * 16 + i) * 2, vr); }
            tot[tg * 128 + d] = cum;
            __syncthreads();
            const float t0v = tot[d], t1v = tot[128 + d], t2v = tot[256 + d], t3v = tot[384 + d];
            const float off = (tg > 0 ? t0v : 0.f) + (tg > 1 ? t1v : 0.f) + (tg > 2 ? t2v : 0.f), gm = t0v + t1v, gl = gm + t2v + t3v;
#pragma unroll
            for (int i = 0; i < 16; ++i) { const float g = off + cv[i]; const int tl = tg * 16 + i;
                ST16(oQs + tl * PQB + d * 2, f2bf(qv[i] * __expf(g - gm))); ST16(oKs + tl * PQB + d * 2, f2bf(kv[i] * __expf(gm - g))); ST16(oKh + d * P64B + tl * 2, f2bf(kv[i] * __expf(gl - g))); }
            if (tg == 0) { egm[d] = __expf(gm); egl[d] = __expf(gl); gsum += gl; }
            __syncthreads();
        }
        if constexpr (KIND == 2) {
            const int d = tid & 63, tg = tid >> 6, ts = t0 + tg * 8;
            float qv[8], kv[8], cv[8]; float cum = 0.f;
            const bf16_t* src = BIG + (size_t)ts * LD;
#pragma unroll
            for (int i = 0; i < 8; ++i) { const bf16_t* row = src + i * LD; const float qr = bf2f(row[2560 + h * 64 + d]) * 0.125f, kr = bf2f(row[2816 + h * 64 + d]);
                const u32x4 ga = *(const u32x4*)(row + 3584), gb = *(const u32x4*)(row + 3592);
                float lg = c_bg;
                lg += bflo(ga.x) * wup[0] + bfhi(ga.x) * wup[1] + bflo(ga.y) * wup[2] + bfhi(ga.y) * wup[3] + bflo(ga.z) * wup[4] + bfhi(ga.z) * wup[5] + bflo(ga.w) * wup[6] + bfhi(ga.w) * wup[7];
                lg += bflo(gb.x) * wup[8] + bfhi(gb.x) * wup[9] + bflo(gb.y) * wup[10] + bfhi(gb.y) * wup[11] + bflo(gb.z) * wup[12] + bfhi(gb.z) * wup[13] + bflo(gb.w) * wup[14] + bfhi(gb.w) * wup[15];
                cum += logsigm(lg) * 0.0625f; qv[i] = qr; kv[i] = kr; cv[i] = cum; }
            tot[tg * 128 + d] = cum;
            { const int v = tid & 127, tgv = tid >> 7; const bf16_t* vs = BIG + (size_t)(t0 + tgv * 16) * LD + 3072 + h * 128 + v;
#pragma unroll
                for (int i = 0; i < 16; ++i) ST16(oVt + v * P64B + (tgv * 16 + i) * 2, vs[i * LD]); }
            __syncthreads();
            float off = 0.f, gm = 0.f, gl = 0.f;
#pragma unroll
            for (int g2 = 0; g2 < 8; ++g2) { const float tv = tot[g2 * 128 + d]; if (g2 < tg) off += tv; if (g2 < 4) gm += tv; gl += tv; }
#pragma unroll
            for (int i = 0; i < 8; ++i) { const float g = off + cv[i]; const int tl = tg * 8 + i;
                ST16(oQs + tl * PQB + d * 2, f2bf(qv[i] * __expf(g - gm))); ST16(oKs + tl * PQB + d * 2, f2bf(kv[i] * __expf(gm - g))); ST16(oKh + d * P64B + tl * 2, f2bf(kv[i] * __expf(gl - g))); }
            if (tg == 0) { egm[d] = __expf(gm); egl[d] = __expf(gl); gsum += gl; }
            __syncthreads();
        }
        f32x4 accO[NVW]; const int lrow = 16 * lt + r16;
        if constexpr (MODE == 1) {
#pragma unroll
        for (int i = 0; i < NT; ++i) { const int v = 16 * (vt0 + i) + r16, d0 = 16 * dti + 4 * q4; f32x4 s = accS[i];
            if constexpr (KIND != 0) { const f32x4 e = *(const LAS f32x4*)(egm + d0); s = s * e; }
            u32x2 wv; wv.x = pk2(s[0], s[1]); wv.y = pk2(s[2], s[3]); *(LAS u32x2*)(lds + oST + v * PQB + d0 * 2) = wv; }
#pragma unroll
        for (int e = 0; e < 2; ++e) { const int st = 2 * wh + e; f32x4 a = {0.f, 0.f, 0.f, 0.f};
            if (st <= lt) {
#pragma unroll
                for (int ks = 0; ks < KS; ++ks) { const int kb0 = ks * 64 + q4 * 16; a = MFMA16(FRAG(oKs, 16 * st + r16, PQB), FRAG(oQs, 16 * lt + r16, PQB), a); }
                const int l = 16 * lt + r16, s0 = 16 * st + 4 * q4;
#pragma unroll
                for (int j = 0; j < 4; ++j) { float dec = 1.f; if constexpr (KIND == 0) dec = __expf(fminf(acum[l] - acum[s0 + j], 0.f)); a[j] = (s0 + j <= l) ? a[j] * dec : 0.f; }
            }
            u32x2 wv; wv.x = pk2(a[0], a[1]); wv.y = pk2(a[2], a[3]); *(LAS u32x2*)(lds + oAt + (16 * lt + r16) * P64B + (16 * st + 4 * q4) * 2) = wv; }
        __syncthreads();
        {
            bf16x8 qf[KS];
#pragma unroll
            for (int ks = 0; ks < KS; ++ks) { const int kb0 = ks * 64 + q4 * 16; qf[ks] = FRAG(oQs, 16 * lt + r16, PQB); }
#pragma unroll
            for (int i = 0; i < NVW; ++i) { const int vt = wh * NVW + i; f32x4 a = {0.f, 0.f, 0.f, 0.f};
#pragma unroll
                for (int ks = 0; ks < KS; ++ks) { const int kb0 = ks * 64 + q4 * 16; a = MFMA16(FRAG(oST, 16 * vt + r16, PQB), qf[ks], a); }
                if constexpr (KIND == 0) a = a * __expf(acum[16 * lt + r16]);
                accO[i] = a; }
#pragma unroll
            for (int ks = 0; ks < 2; ++ks) { if (ks * 32 <= 16 * lt + 15) { const int kb0 = ks * 64 + q4 * 16; const bf16x8 af = FRAG(oAt, 16 * lt + r16, P64B);
#pragma unroll
                for (int i = 0; i < NVW; ++i) accO[i] = MFMA16(FRAG(oVt, 16 * (wh * NVW + i) + r16, P64B), af, accO[i]); } }
        }
        if constexpr (KIND == 0) {
#pragma unroll
            for (int i = 0; i < NVW; ++i) { const int p0 = 16 * (wh * NVW + i) + 4 * q4; bf16_t* zp = BIG + (size_t)(t0 + lrow) * LD + h * 64 + p0;
                const u32x2 z = *(const u32x2*)zp; const u32x2 xs = *(const LAS u32x2*)(lds + oXs + lrow * P64B + p0 * 2); const f32x4 a = accO[i]; u32x2 wv;
                wv.x = pk2((a[0] + c_Dh * bflo(xs.x)) * silu(bflo(z.x)), (a[1] + c_Dh * bfhi(xs.x)) * silu(bfhi(z.x)));
                wv.y = pk2((a[2] + c_Dh * bflo(xs.y)) * silu(bflo(z.y)), (a[3] + c_Dh * bfhi(xs.y)) * silu(bfhi(z.y))); *(u32x2*)zp = wv; }
        } else {
            float ss = 0.f;
#pragma unroll
            for (int i = 0; i < NVW; ++i) ss += (accO[i][0] * accO[i][0] + accO[i][1] * accO[i][1]) + (accO[i][2] * accO[i][2] + accO[i][3] * accO[i][3]);
            ss += __shfl_xor(ss, 16); ss += __shfl_xor(ss, 32);
            if (q4 == 0) red[lrow * 2 + wh] = ss;
        }
        }
#pragma unroll
        for (int i = 0; i < NT; ++i) { const int d0 = 16 * dti + 4 * q4; f32x4 s = accS[i];
            if constexpr (KIND == 0) s = s * eglS; else { const f32x4 e = *(const LAS f32x4*)(egl + d0); s = s * e; }
#pragma unroll
            for (int ks = 0; ks < 2; ++ks) { const int kb0 = ks * 64 + q4 * 16; s = MFMA16(FRAG(oKh, 16 * dti + r16, P64B), FRAG(oVt, 16 * (vt0 + i) + r16, P64B), s); }
            accS[i] = s; }
        __syncthreads();
        if constexpr (KIND != 0 && MODE == 1) {
            const float rstd = 1.0f / sqrtf((red[lrow * 2] + red[lrow * 2 + 1]) * (1.f / 128.f) + EPS_);
            const float* nw = (KIND == 1 ? P.in[30] : P.in[33]) + h * 128; const int gofs = (KIND == 1 ? 0 : 512) + h * 128;
#pragma unroll
            for (int i = 0; i < NVW; ++i) { const int v0 = 16 * (wh * NVW + i) + 4 * q4; bf16_t* gp = BIG + (size_t)(t0 + lrow) * LD + gofs + v0;
                const u32x2 gt = *(const u32x2*)gp; const f32x4 nv = *(const f32x4*)(nw + v0); const f32x4 a = accO[i] * rstd * nv; u32x2 wv;
                wv.x = pk2(a[0] * silu(bflo(gt.x)), a[1] * silu(bfhi(gt.x))); wv.y = pk2(a[2] * silu(bflo(gt.y)), a[3] * silu(bfhi(gt.y))); *(u32x2*)gp = wv; }
        }
    }
    if constexpr (MODE == 0) {
        float* rec = stbase + (size_t)seg * REC;
#pragma unroll
        for (int i = 0; i < NT; ++i) *(f32x4*)(rec + ((size_t)(w * NT + i) * 64 + lane) * 4) = accS[i];
        if constexpr (KIND == 0) { if (tid == 0) rec[DK * DV] = gsum; }
        else { if (tid < DK) rec[DK * DV + tid] = gsum; }
    }
}
template <int MODE>
DI void s5_wave(const Params& P, LAS unsigned char* wl  , const int b, const int g, const int seg, float* hst  ) {
    const int lane = otid() & 63, r16 = lane & 15, q4 = lane >> 4;
    LAS float* bu = (LAS float*)wl;
    LAS bf16_t* hb = (LAS bf16_t*)(wl + 16 * 132 * 4);
    const float* ltab = (const float*)(P.ws + OFF_S5L) + (size_t)(g * 64 + lane) * 2; const float lbr = ltab[0], lbi = ltab[1];
    const float* btab = (const float*)(P.ws + OFF_S5B) + (size_t)g * 128 * 16;
    bf16x8 bfr[8];
#pragma unroll
    for (int j = 0; j < 8; ++j) { u32x4 wv = {0u, 0u, 0u, 0u};
        if (q4 < 2) { const float* s = btab + (16 * j + r16) * 16 + 8 * q4; wv.x = pk2(s[0], s[1]); wv.y = pk2(s[2], s[3]); wv.z = pk2(s[4], s[5]); wv.w = pk2(s[6], s[7]); }
        bfr[j] = __builtin_bit_cast(bf16x8, wv); }
    bf16x8 cfr[4];
#pragma unroll
    for (int ks = 0; ks < 4; ++ks) { const int n0 = 32 * ks + 8 * q4; float v[8];
#pragma unroll
        for (int i = 0; i < 8; ++i) { const int n = n0 + i; v[i] = n < 64 ? P.in[22][(size_t)(g * 16 + r16) * 64 + n] : -P.in[23][(size_t)(g * 16 + r16) * 64 + n - 64]; }
        u32x4 wv; wv.x = pk2(v[0], v[1]); wv.y = pk2(v[2], v[3]); wv.z = pk2(v[4], v[5]); wv.w = pk2(v[6], v[7]); cfr[ks] = __builtin_bit_cast(bf16x8, wv); }
    float dsk[4];
#pragma unroll
    for (int j = 0; j < 4; ++j) dsk[j] = P.in[24][g * 16 + 4 * q4 + j];
    bf16_t* U = (bf16_t*)(P.ws + OFF_BIG) + (size_t)b * L_ * ABW + 3072 + g * 16;
    float hr = 0.f, hi = 0.f;
    if constexpr (MODE == 1) { float pr = lbr, pi = lbi;
#pragma unroll
        for (int k = 0; k < 9; ++k) { const float nr = pr * pr - pi * pi, ni = 2.f * pr * pi; pr = nr; pi = ni; }
        for (int j = 0; j < seg; ++j) { const float ar = hst[(j * 64 + lane) * 2], ai = hst[(j * 64 + lane) * 2 + 1]; const float nr = pr * hr - pi * hi + ar, ni = pr * hi + pi * hr + ai; hr = nr; hi = ni; } }
    const int c0 = seg * 8;
    u32x4 an[4]; u32x2 un[4];
#pragma unroll
    for (int s = 0; s < 4; ++s) { an[s] = (u32x4){0u, 0u, 0u, 0u}; if (q4 < 2) an[s] = *(const u32x4*)(U + (size_t)(c0 * 64 + s * 16 + r16) * ABW + 8 * q4); un[s] = *(const u32x2*)(U + (size_t)(c0 * 64 + s * 16 + r16) * ABW + 4 * q4); }
    for (int c = c0; c < c0 + 8; ++c) {
        u32x4 ac[4]; u32x2 uc[4];
#pragma unroll
        for (int s = 0; s < 4; ++s) { ac[s] = an[s]; uc[s] = un[s]; }
        if (c < c0 + 7) {
#pragma unroll
            for (int s = 0; s < 4; ++s) { const bf16_t* up = U + (size_t)((c + 1) * 64 + s * 16 + r16) * ABW; if (q4 < 2) an[s] = *(const u32x4*)(up + 8 * q4); un[s] = *(const u32x2*)(up + 4 * q4); }
        }
#pragma unroll
        for (int s = 0; s < 4; ++s) {
            const bf16x8 af = __builtin_bit_cast(bf16x8, ac[s]);
#pragma unroll
            for (int j = 0; j < 8; ++j) { f32x4 a = {0.f, 0.f, 0.f, 0.f}; a = MFMA16(af, bfr[j], a);
#pragma unroll
                for (int jj = 0; jj < 4; ++jj) bu[(4 * q4 + jj) * 132 + 16 * j + r16] = a[jj]; }
            __builtin_amdgcn_fence(__ATOMIC_RELEASE, "wavefront"); __builtin_amdgcn_wave_barrier(); __builtin_amdgcn_fence(__ATOMIC_ACQUIRE, "wavefront");
#pragma unroll
            for (int t = 0; t < 16; ++t) { const float re = bu[t * 132 + lane], im = bu[t * 132 + 64 + lane];
                const float nr = lbr * hr - lbi * hi + re, ni = lbr * hi + lbi * hr + im; hr = nr; hi = ni;
                if constexpr (MODE == 1) { hb[t * 136 + lane] = f2bf(hr); hb[t * 136 + 64 + lane] = f2bf(hi); } }
            __builtin_amdgcn_fence(__ATOMIC_RELEASE, "wavefront"); __builtin_amdgcn_wave_barrier(); __builtin_amdgcn_fence(__ATOMIC_ACQUIRE, "wavefront");
            if constexpr (MODE == 1) {
            f32x4 y = {0.f, 0.f, 0.f, 0.f};
#pragma unroll
            for (int ks = 0; ks < 4; ++ks) { const bf16x8 hf = *(const LAS bf16x8*)(hb + r16 * 136 + 32 * ks + 8 * q4); y = MFMA16(cfr[ks], hf, y); }
            const float u0 = bflo(uc[s].x), u1 = bfhi(uc[s].x), u2 = bflo(uc[s].y), u3 = bfhi(uc[s].y); u32x2 wv;
            wv.x = pk2(gelu_t(y[0] + dsk[0] * u0), gelu_t(y[1] + dsk[1] * u1)); wv.y = pk2(gelu_t(y[2] + dsk[2] * u2), gelu_t(y[3] + dsk[3] * u3));
            *(u32x2*)(U + (size_t)(c * 64 + s * 16 + r16) * ABW + 4 * q4) = wv;
            }
            __builtin_amdgcn_wave_barrier();
        }
    }
    if constexpr (MODE == 0) { hst[(seg * 64 + lane) * 2] = hr; hst[(seg * 64 + lane) * 2 + 1] = hi; }
}
constexpr size_t OFF_XB2 = OFF_PB + (size_t)T_ * 256 * 2;
static_assert(OFF_XB2 + (size_t)T_ * 1024 * 2 <= OFF_BIG + SZ_BIG, "BIG tail");
constexpr size_t OFF_BAR = (WS_END + 255) & ~(size_t)255;
constexpr size_t WS_TOTAL = OFF_BAR + XCD_BAR_WORDS * 4;
__global__ void __launch_bounds__(512, 2) mega(Params P) {
    extern __shared__ __attribute__((aligned(16))) unsigned char shm[];
    LAS unsigned char* lds = (LAS unsigned char*)shm;
    cg::grid_group grid = cg::this_grid();
    unsigned char* ws = P.ws;
    bf16_t* XB = (bf16_t*)(ws + OFF_XB); bf16_t* XB2 = (bf16_t*)(ws + OFF_XB2); bf16_t* BIG = (bf16_t*)(ws + OFF_BIG); bf16_t* PB = (bf16_t*)(ws + OFF_PB); float* PP = (float*)(ws + OFF_BIG); float* X = P.out;
    const int wave = __builtin_amdgcn_readfirstlane(otid() >> 6);
    unsigned* barw = (unsigned*)(ws + OFF_BAR); volatile LAS unsigned* bst = (volatile LAS unsigned*)(lds + LDS_BYTES - 16);
    if (otid() < 2) bst[otid()] = 0u;
    if (blockIdx.x == 0) for (int i = otid(); i < XCD_BAR_WORDS; i += 512) barw[i] = 0u;
    __syncthreads();
    p0_phase(P, lds);
    grid.sync();
    const XcdBarrier xb = xcd_barrier_post(barw, bst);
#define GSYNC() xcd_barrier(xb)
#ifdef PROBE_SYNC
    for (int k = 0; k < 20; ++k) GSYNC();
#endif
#ifdef PROBE_P0
    p0_phase(P, lds); GSYNC();
#endif
#pragma unroll 1
    for (int l = 0; l < 2; ++l) {
        const float* lng = P.in[2] + (size_t)l * 3 * D_; const float* lnb = P.in[3] + (size_t)l * 3 * D_;
        run_gemm(lds, l == 0 ? XB : XB2, D_, (const bf16_t*)(ws + OFF_WGU + (size_t)(l * 2) * SZ_WGU), 5632, D_, EpiSwiGLU{BIG}); GSYNC();
#ifdef PROBE_GU
        run_gemm(lds, l == 0 ? XB : XB2, D_, (const bf16_t*)(ws + OFF_WGU + (size_t)(l * 2) * SZ_WGU), 5632, D_, EpiSwiGLU{BIG}); GSYNC();
#endif
        run_gemm(lds, BIG, FF_, (const bf16_t*)(ws + OFF_WD + (size_t)(l * 2) * SZ_WD), D_, FF_, EpiRes{l == 0 ? P.in[0] : X, X, 0.5f}); GSYNC();
        ln_phase(X, XB, lng, lnb); GSYNC();
        if (l == 0) {
            run_gemm(lds, XB, D_, (const bf16_t*)(ws + OFF_WABIN), ABW, D_, EpiBf16{BIG, ABW}); GSYNC();
            {
                float* stb = (float*)(ws + OFF_XB); float* s5b = stb + (size_t)64 * 4 * (128 * 64 + 128);
                for (int it = blockIdx.x; it < 256; it += gridDim.x) {
                    { const int bb = it >> 6, hh = (it >> 2) & 15, sg = it & 3; if (sg < 3) cla_item<0, 0, 4>(P, lds, bb, hh, sg, stb + (size_t)((bb * 16 + hh) * 4) * (128 * 64 + 128)); }
                    __syncthreads();
                    { const int bb = it >> 6, gg = it & 63; if (wave < 7) s5_wave<0>(P, lds + wave * 13312, bb, gg, wave, s5b + (size_t)((bb * 64 + gg) * 8) * 128); }
                    __syncthreads();
                }
                GSYNC();
                for (int it = blockIdx.x; it < 256; it += gridDim.x) {
                    { const int bb = it >> 6, hh = (it >> 2) & 15, sg = it & 3; cla_item<0, 1, 4>(P, lds, bb, hh, sg, stb + (size_t)((bb * 16 + hh) * 4) * (128 * 64 + 128)); }
                    __syncthreads();
                    { const int bb = it >> 6, gg = it & 63; s5_wave<1>(P, lds + wave * 13312, bb, gg, wave, s5b + (size_t)((bb * 64 + gg) * 8) * 128); }
                    __syncthreads();
                }
            }
            GSYNC();
            run_gemm(lds, BIG + 3072, ABW, (const bf16_t*)(ws + OFF_WGLU), D_, D_, EpiGLU{BIG + 3072, BIG + 1024, P.in[26]});
            ssd_rms_phase(BIG, P.in[16]); GSYNC();
            run_gemm(lds, BIG, ABW, (const bf16_t*)(ws + OFF_WABOUT), D_, 2048, EpiRes{X, X, 1.0f}); GSYNC();
        } else {
            run_gemm(lds, XB, D_, (const bf16_t*)(ws + OFF_WCDIN), CDW, D_, EpiBf16{BIG, CDW}); GSYNC();
            {
                float* stb1 = (float*)(ws + OFF_XB); float* stb2 = stb1 + (size_t)16 * 8 * (128 * 128 + 128);
                for (int it = blockIdx.x; it < 256; it += gridDim.x) { const int rem = it & 127, bb = rem >> 5, hh = (rem >> 3) & 3, sg = rem & 7;
                    if (sg < 7) { if (it < 128) cla_item<1, 0, 8>(P, lds, bb, hh, sg, stb1 + (size_t)((bb * 4 + hh) * 8) * (128 * 128 + 128));
                                  else cla_item<2, 0, 8>(P, lds, bb, hh, sg, stb2 + (size_t)((bb * 4 + hh) * 8) * (64 * 128 + 128)); }
                    __syncthreads(); }
                GSYNC();
                for (int it = blockIdx.x; it < 256; it += gridDim.x) { const int rem = it & 127, bb = rem >> 5, hh = (rem >> 3) & 3, sg = rem & 7;
                    if (it < 128) cla_item<1, 1, 8>(P, lds, bb, hh, sg, stb1 + (size_t)((bb * 4 + hh) * 8) * (128 * 128 + 128));
                    else cla_item<2, 1, 8>(P, lds, bb, hh, sg, stb2 + (size_t)((bb * 4 + hh) * 8) * (64 * 128 + 128));
                    __syncthreads(); }
            }
            GSYNC();
            run_gemm(lds, BIG, CDW, (const bf16_t*)(ws + OFF_WCDOUT), D_, D_, EpiRes{X, X, 1.0f}); GSYNC();
        }
        ln_phase(X, XB, lng + D_, lnb + D_); GSYNC();
        run_gemm(lds, XB, D_, (const bf16_t*)(ws + OFF_WGU + (size_t)(l * 2 + 1) * SZ_WGU), 5632, D_, EpiSwiGLU{BIG}); GSYNC();
        run_gemm(lds, BIG, FF_, (const bf16_t*)(ws + OFF_WD + (size_t)(l * 2 + 1) * SZ_WD), D_, FF_, EpiRes{X, X, 0.5f}); GSYNC();
        ln_phase(X, XB, lng + 2 * D_, lnb + 2 * D_); p_to_bf16(P.in[1] + (size_t)l * T_ * 256, PB); GSYNC();
        run_gemm(lds, PB, 256, (const bf16_t*)(ws + OFF_WPP + (size_t)l * SZ_WPP), D_, 256, EpiF32{PP});
        run_gemm(lds, XB, D_, (const bf16_t*)(ws + OFF_WPG + (size_t)l * SZ_W1K), D_, D_, EpiPLE{X, PP, XB2});
        if (l == 0) GSYNC();
    }
}

extern "C" void kernel_launch(void* const* d_in, const int* in_sizes, int n_in, void* d_out, int out_size, void* d_ws, size_t ws_size, hipStream_t stream) {
    static int grid = 0;
    if (grid == 0) {
        if (n_in != 34 || out_size != T_ * D_ || ws_size < WS_TOTAL) { fprintf(stderr, "kernel_launch: unexpected shapes (n_in %d, out %d, ws %zu < %zu)\n", n_in, out_size, ws_size, (size_t)WS_TOTAL); grid = -1; return; }
        int dev = 0, cus = 0, per_cu = 0;
        hipGetDevice(&dev); hipDeviceGetAttribute(&cus, hipDeviceAttributeMultiprocessorCount, dev);
        if (hipFuncSetAttribute((const void*)mega, hipFuncAttributeMaxDynamicSharedMemorySize, LDS_BYTES) != hipSuccess) { fprintf(stderr, "kernel_launch: hipFuncSetAttribute failed\n"); grid = -1; return; }
        if (hipOccupancyMaxActiveBlocksPerMultiprocessor(&per_cu, (const void*)mega, 512, LDS_BYTES) != hipSuccess || per_cu < 1) { fprintf(stderr, "kernel_launch: occupancy query says %d\n", per_cu); per_cu = 1; }
        (void)hipGetLastError();
        grid = cus * per_cu;
    }
    if (grid < 0) return;
    Params P{};
    for (int i = 0; i < 34; ++i) P.in[i] = (const float*)d_in[i];
    P.out = (float*)d_out; P.ws = (unsigned char*)d_ws;
    void* args[] = {&P};
    hipError_t e = hipLaunchCooperativeKernel((const void*)mega, dim3(grid), dim3(512), args, LDS_BYTES, stream);
    if (e != hipSuccess) fprintf(stderr, "cooperative launch failed: %s (grid %d)\n", hipGetErrorString(e), grid);
}
```

```cpp
#include <hip/hip_runtime.h>
#include <hip/hip_cooperative_groups.h>
#include <cstdio>
namespace cg = cooperative_groups;
namespace pg8 {
#define PG8_LAS __attribute__((address_space(3)))
typedef unsigned short bf16_t;
typedef short bf16x8 __attribute__((ext_vector_type(8)));
typedef float f32x4 __attribute__((ext_vector_type(4)));
typedef unsigned u32x4 __attribute__((ext_vector_type(4)));
constexpr int BM = 256, BK = 64, HALF = 128, HTB = HALF * BK * 2  , STAGE_BYTES = 8 * HTB, NXCD = 8, WGM = 8;

__host__ __device__ __forceinline__ int lds_byte(int r, int c) { const int st = (r >> 4) * 2 + (c >> 5), rr = r & 15, cc = c & 31, ob = rr * 64 + cc * 2; return st * 1024 + (ob ^ (((ob >> 9) & 1) << 5)); }
__host__ __device__ __forceinline__ void stage_rc(int b, int& R, int& C) { const int st = b / 1024, sb = b % 1024, swz = sb ^ (((sb >> 9) & 1) << 5); R = (st >> 1) * 16 + swz / 64; C = (st & 1) * 32 + (swz % 64) / 2; }
__host__ __device__ __forceinline__ int perm32(int rho) { const int n = rho >> 4, i = rho & 15; return 8 * (i >> 2) + 4 * n + (i & 3); }

struct Unit { int pm, pn; };
struct Gemm { const bf16_t* A; const bf16_t* Bt; int M, N, K, lda; };

struct StaticOrder {
    int nM, nN, nwg, G, c;
    __host__ __device__ void init(int M, int N, int G_, int c_) { nM = M / BM; nN = N / BM; nwg = nM * nN; G = G_; c = c_; }
    __host__ __device__ bool next(int i, Unit& u) const {
        const long L = (long)i * G + c; if (L >= nwg) return false;
        int wgid = (int)L; { const int q = nwg / NXCD, r = nwg % NXCD, xcd = wgid % NXCD, off = wgid / NXCD; wgid = (xcd < r ? xcd * (q + 1) : r * (q + 1) + (xcd - r) * q) + off; }
        const int nig = WGM * nN, gid = wgid / nig, fm = gid * WGM, gsz = (nM - fm) < WGM ? (nM - fm) : WGM;
        u.pm = fm + ((wgid % nig) % gsz); u.pn = (wgid % nig) / gsz; return true;
    }
    __device__ __forceinline__ void a_ready(const Unit&) const {}
    __device__ __forceinline__ void done(const Unit&) const {}
};
__device__ __forceinline__ unsigned cvt_pk_bf16(float lo, float hi) { unsigned r; asm volatile("v_cvt_pk_bf16_f32 %0, %1, %2" : "=v"(r) : "v"(lo), "v"(hi)); return r; }
template <class Epi, class Sched, bool STAMP = false>
__device__ __forceinline__ void gemm_phase(PG8_LAS unsigned char* lds, const Gemm g, const Sched& S, const Epi& E, unsigned long long* stamps) {
    int tid_o = threadIdx.x; asm volatile("" : "+v"(tid_o)); const int tid = tid_o, wid = __builtin_amdgcn_readfirstlane(tid >> 6), lane = tid & 63, wr = wid >> 2, wc = wid & 3, fr = lane & 15, fq = lane >> 4;
    const int K = g.K, nt = K / BK;
    int ts_lo = 0, ts_hi = 0, nts = 0; const unsigned long long rt_entry = STAMP ? (unsigned long long)wall_clock64() : 0ull;
#define PG8_STAMP() do { if (STAMP && wid == 0 && nts < 64) { const unsigned long long _c = (unsigned long long)clock64(); \
        ts_lo = (lane == nts) ? (int)(unsigned)_c : ts_lo; ts_hi = (lane == nts) ? (int)(unsigned)(_c >> 32) : ts_hi; ++nts; } } while (0)
    PG8_STAMP();
    unsigned voffA[2], voffB[2];
#pragma unroll
    for (int i = 0; i < 2; ++i) { int R, C; stage_rc(tid * 16 + i * 8192, R, C); const int Rb = Epi::PERM ? ((R & ~31) + perm32(R & 31)) : R;
        voffA[i] = (unsigned)(R * g.lda + C) * 2u; voffB[i] = (unsigned)(Rb * K + C) * 2u; }
    const size_t kstep = (size_t)(BK * 2);
    const size_t hstepB = (size_t)HALF * K * 2, hstepA = (size_t)HALF * g.lda * 2;
    const size_t tstepA = 2 * hstepA, tstepB = 2 * hstepB;
    const unsigned ldsw = (unsigned)wid * 1024u;
    const int aoff = lds_byte(wr * 64 + fr, fq * 8), boff = lds_byte(wc * 32 + fr, fq * 8);
#define PG8_SA(b, h) (((b) * 2 + (h)) * HTB)
#define PG8_SB(b, h) ((4 + (b) * 2 + (h)) * HTB)
#define PG8_STAGE(bufoff, gbase, voff) do { _Pragma("unroll") for (int _i = 0; _i < 2; ++_i) \
        __builtin_amdgcn_global_load_lds((const unsigned*)((const char*)(gbase) + (voff)[_i]), (PG8_LAS unsigned*)(lds + (bufoff) + ldsw + _i * 8192), 16, 0, 0); } while (0)
#define PG8_LDA(dst, b, h) do { _Pragma("unroll") for (int m = 0; m < 4; ++m) _Pragma("unroll") for (int k = 0; k < 2; ++k) dst[m][k] = *(const PG8_LAS bf16x8*)(lds + PG8_SA(b, h) + aoff + m * 2048 + k * 1024); } while (0)
#define PG8_LDB(dst, b, h) do { _Pragma("unroll") for (int n = 0; n < 2; ++n) _Pragma("unroll") for (int k = 0; k < 2; ++k) dst[n][k] = *(const PG8_LAS bf16x8*)(lds + PG8_SB(b, h) + boff + n * 2048 + k * 1024); } while (0)
#define PG8_MMA(ai, bj, At, Bt) do { __builtin_amdgcn_s_setprio(1); _Pragma("unroll") for (int m = 0; m < 4; ++m) _Pragma("unroll") for (int n = 0; n < 2; ++n) _Pragma("unroll") for (int k = 0; k < 2; ++k) \
        acc[ai][bj][m][n] = __builtin_amdgcn_mfma_f32_16x16x32_bf16(Bt[n][k], At[m][k], acc[ai][bj][m][n], 0, 0, 0); __builtin_amdgcn_s_setprio(0); } while (0)
#define PG8_WAIT_V(n) asm volatile("s_waitcnt vmcnt(" #n ")" ::: "memory")
#define PG8_WAIT_L(n) asm volatile("s_waitcnt lgkmcnt(" #n ")" ::: "memory")
#define PG8_BAR __builtin_amdgcn_s_barrier()
#define PG8_SCHED __builtin_amdgcn_sched_barrier(0)
    Unit cur, nxt; int ui = 0;
    if (!S.next(0, cur)) return;
    f32x4 acc[2][2][4][2];
#pragma unroll
    for (int a = 0; a < 2; ++a)
#pragma unroll
        for (int b = 0; b < 2; ++b)
#pragma unroll
            for (int m = 0; m < 4; ++m)
#pragma unroll
                for (int n = 0; n < 2; ++n) acc[a][b][m][n] = (f32x4){0.f, 0.f, 0.f, 0.f};
    bf16x8 At[4][2], B0[2][2], B1[2][2];
    const char* cA = (const char*)g.A + (size_t)cur.pm * tstepA; const char* cB = (const char*)g.Bt + (size_t)cur.pn * tstepB;
    S.a_ready(cur);
    PG8_STAGE(PG8_SB(0, 0), cB, voffB); PG8_STAGE(PG8_SA(0, 0), cA, voffA); PG8_STAGE(PG8_SB(0, 1), cB + hstepB, voffB); PG8_STAGE(PG8_SA(0, 1), cA + hstepA, voffA);
    if (wr == 1) PG8_BAR;
    PG8_WAIT_V(4); PG8_BAR;
    PG8_STAGE(PG8_SB(1, 0), cB + kstep, voffB); PG8_STAGE(PG8_SA(1, 0), cA + kstep, voffA); PG8_STAGE(PG8_SB(1, 1), cB + hstepB + kstep, voffB);
    PG8_WAIT_V(6); PG8_BAR;
    PG8_STAMP();
    for (;;) {
        const bool has_next = S.next(ui + 1, nxt);
        const char* nA = has_next ? (const char*)g.A + (size_t)nxt.pm * tstepA : cA; const char* nB = has_next ? (const char*)g.Bt + (size_t)nxt.pn * tstepB : cB;
        for (int t = 0; t < nt; t += 2) {
            const bool last = (t == nt - 2);
            const char* a1 = cA + (size_t)(t + 1) * kstep;
            const char* a2 = last ? nA : cA + (size_t)(t + 2) * kstep; const char* b2 = last ? nB : cB + (size_t)(t + 2) * kstep;
            const char* a3 = a2 + kstep; const char* b3 = b2 + kstep;
            if (last && has_next) S.a_ready(nxt);
            PG8_LDB(B0, 0, 0); PG8_SCHED; PG8_LDA(At, 0, 0); PG8_STAGE(PG8_SA(1, 1), a1 + hstepA, voffA);
            PG8_WAIT_L(8); PG8_BAR; PG8_WAIT_L(0); PG8_MMA(0, 0, At, B0); PG8_BAR; PG8_SCHED;
            PG8_LDB(B1, 0, 1); PG8_STAGE(PG8_SB(0, 0), b2, voffB);
            PG8_BAR; PG8_WAIT_L(0); PG8_MMA(0, 1, At, B1); PG8_BAR;
            PG8_LDA(At, 0, 1); PG8_STAGE(PG8_SA(0, 0), a2, voffA);
            PG8_BAR; PG8_WAIT_L(0); PG8_MMA(1, 0, At, B0); PG8_BAR; PG8_SCHED;
            PG8_STAGE(PG8_SB(0, 1), b2 + hstepB, voffB);
            PG8_WAIT_V(6); PG8_BAR; PG8_MMA(1, 1, At, B1); PG8_BAR;
            PG8_LDB(B0, 1, 0); PG8_SCHED; PG8_LDA(At, 1, 0); PG8_STAGE(PG8_SA(0, 1), a2 + hstepA, voffA);
            PG8_WAIT_L(8); PG8_BAR; PG8_WAIT_L(0); PG8_MMA(0, 0, At, B0); PG8_BAR; PG8_SCHED;
            PG8_LDB(B1, 1, 1); PG8_STAGE(PG8_SB(1, 0), b3, voffB);
            PG8_BAR; PG8_WAIT_L(0); PG8_MMA(0, 1, At, B1); PG8_BAR;
            PG8_LDA(At, 1, 1); PG8_STAGE(PG8_SA(1, 0), a3, voffA);
            PG8_BAR; PG8_WAIT_L(0); PG8_MMA(1, 0, At, B0); PG8_BAR; PG8_SCHED;
            PG8_STAGE(PG8_SB(1, 1), b3 + hstepB, voffB);
            PG8_WAIT_V(6); PG8_BAR; PG8_MMA(1, 1, At, B1); PG8_BAR;
        }
        PG8_STAMP();
        if constexpr (!Epi::AFTER_DRAIN) { E(acc, cur, wr, wc, fr, fq); S.done(cur); }
        PG8_STAMP();
        if (!has_next) break;
#pragma unroll
        for (int a = 0; a < 2; ++a)
#pragma unroll
            for (int b = 0; b < 2; ++b)
#pragma unroll
                for (int m = 0; m < 4; ++m)
#pragma unroll
                    for (int n = 0; n < 2; ++n) acc[a][b][m][n] = (f32x4){0.f, 0.f, 0.f, 0.f};
        cur = nxt; cA = nA; cB = nB; ++ui;
    }
    PG8_WAIT_V(0);
    if (wr == 0) PG8_BAR;
    PG8_BAR;
    if constexpr (Epi::AFTER_DRAIN) { E.fused(acc, cur, wr, wc, fr, fq, lds, wid, lane); S.done(cur); }
    PG8_STAMP();
    if (STAMP && wid == 0) { stamps[lane] = lane < nts ? (((unsigned long long)(unsigned)ts_hi << 32) | (unsigned)ts_lo) : 0ull;
        if (lane == 62) stamps[62] = rt_entry; if (lane == 63) stamps[63] = (unsigned long long)wall_clock64(); }
#undef PG8_STAMP
#undef PG8_SA
#undef PG8_SB
#undef PG8_STAGE
#undef PG8_LDA
#undef PG8_LDB
#undef PG8_MMA
#undef PG8_WAIT_V
#undef PG8_WAIT_L
#undef PG8_BAR
#undef PG8_SCHED
}
}
#define LAS __attribute__((address_space(3)))
#define DI __device__ __forceinline__
using pg8::bf16_t; using pg8::bf16x8; using pg8::f32x4; using pg8::u32x4;
typedef unsigned u32x2 __attribute__((ext_vector_type(2)));

constexpr int T_ = 16384, D_ = 1024, FF_ = 2816, L_ = 4096;
constexpr int ABW = 4352, CDW = 3840;
constexpr float DN_ALPHA = 1.41421356237f, EPS_ = 1e-5f;
constexpr int LDS_BYTES = 144 * 1024;

constexpr size_t SZ_WGU = (size_t)5632 * 1024 * 2, SZ_WD = (size_t)1024 * 2816 * 2, SZ_W1K = (size_t)1024 * 1024 * 2, SZ_WPP = (size_t)1024 * 256 * 2;
constexpr size_t OFF_WGU = 0;
constexpr size_t OFF_WD = OFF_WGU + 4 * SZ_WGU;
constexpr size_t OFF_WPG = OFF_WD + 4 * SZ_WD;
constexpr size_t OFF_WPP = OFF_WPG + 2 * SZ_W1K;
constexpr size_t OFF_WABIN = OFF_WPP + 2 * SZ_WPP;
constexpr size_t OFF_WABOUT = OFF_WABIN + (size_t)ABW * 1024 * 2;
constexpr size_t OFF_WGLU = OFF_WABOUT + (size_t)1024 * 2048 * 2;
constexpr size_t OFF_WCDIN = OFF_WGLU + SZ_W1K;
constexpr size_t OFF_WCDOUT = OFF_WCDIN + (size_t)CDW * 1024 * 2;
constexpr size_t OFF_XB = OFF_WCDOUT + SZ_W1K;
constexpr size_t OFF_BIG = OFF_XB + (size_t)T_ * 1024 * 2;
constexpr size_t SZ_BIG = (size_t)T_ * ABW * 2;
constexpr size_t OFF_PB = OFF_BIG + (size_t)T_ * FF_ * 2;
constexpr size_t OFF_S5L = OFF_BIG + SZ_BIG;
constexpr size_t OFF_S5B = OFF_S5L + 64 * 64 * 2 * 4;
constexpr size_t WS_END = OFF_S5B + (size_t)64 * 128 * 16 * 4;

DI int otid() { int t = threadIdx.x; asm volatile("" : "+v"(t)); return t; }
struct Params { const float* in[34]; float* out; unsigned char* ws; };

DI unsigned pk2(float lo, float hi) { unsigned r; asm("v_cvt_pk_bf16_f32 %0, %1, %2" : "=v"(r) : "v"(lo), "v"(hi)); return r; }
DI float bflo(unsigned w) { return __uint_as_float(w << 16); }
DI float bfhi(unsigned w) { return __uint_as_float(w & 0xffff0000u); }
DI float bf2f(bf16_t b) { return __uint_as_float(((unsigned)b) << 16); }
DI bf16_t f2bf(float f) { return (bf16_t)(pk2(f, 0.f) & 0xffffu); }
DI float sigm(float x) { return 1.f / (1.f + __expf(-x)); }
DI float silu(float x) { return x / (1.f + __expf(-x)); }
DI float softplus(float x) { return x > 20.f ? x : log1pf(__expf(x)); }
DI float logsigm(float x) { return fminf(x, 0.f) - log1pf(__expf(-fabsf(x))); }
DI float gelu_t(float x) { const float u = 0.7978845608f * (x + 0.044715f * x * x * x); return x / (1.f + __expf(-2.f * u)); }

typedef const f32x4 (&AccT)[2][2][4][2];
struct EpiSwiGLU { static constexpr bool PERM = false, AFTER_DRAIN = false; bf16_t* H;
    DI void operator()(AccT acc, const pg8::Unit& u, int wr, int wc, int fr, int fq) const {
        const int row0 = u.pm * 256 + wr * 64 + fr, col0 = u.pn * 128 + wc * 32 + 4 * fq;
#pragma unroll
        for (int ai = 0; ai < 2; ++ai)
#pragma unroll
            for (int m = 0; m < 4; ++m) { bf16_t* rowp = H + (size_t)(row0 + ai * 128 + m * 16) * FF_ + col0;
#pragma unroll
                for (int n = 0; n < 2; ++n) { const f32x4 g = acc[ai][0][m][n], v = acc[ai][1][m][n]; u32x2 w;
                    w.x = pk2(silu(g[0]) * v[0], silu(g[1]) * v[1]); w.y = pk2(silu(g[2]) * v[2], silu(g[3]) * v[3]); *(u32x2*)(rowp + n * 16) = w; } }
    } };
struct EpiRes { static constexpr bool PERM = false, AFTER_DRAIN = false; const float* base; float* out; float scale;
    DI void operator()(AccT acc, const pg8::Unit& u, int wr, int wc, int fr, int fq) const {
        const int row0 = u.pm * 256 + wr * 64 + fr, col0 = u.pn * 256 + wc * 32 + 4 * fq;
#pragma unroll
        for (int ai = 0; ai < 2; ++ai)
#pragma unroll
            for (int m = 0; m < 4; ++m) { const size_t off = (size_t)(row0 + ai * 128 + m * 16) * D_ + col0;
#pragma unroll
                for (int bj = 0; bj < 2; ++bj)
#pragma unroll
                    for (int n = 0; n < 2; ++n) { const size_t o = off + bj * 128 + n * 16; const f32x4 b = *(const f32x4*)(base + o); *(f32x4*)(out + o) = b * DN_ALPHA + acc[ai][bj][m][n] * scale; } }
    } };
struct EpiBf16 { static constexpr bool PERM = false, AFTER_DRAIN = false; bf16_t* O; int ldc;
    DI void operator()(AccT acc, const pg8::Unit& u, int wr, int wc, int fr, int fq) const {
        const int row0 = u.pm * 256 + wr * 64 + fr, col0 = u.pn * 256 + wc * 32 + 4 * fq;
#pragma unroll
        for (int ai = 0; ai < 2; ++ai)
#pragma unroll
            for (int m = 0; m < 4; ++m) { bf16_t* rowp = O + (size_t)(row0 + ai * 128 + m * 16) * ldc + col0;
#pragma unroll
                for (int bj = 0; bj < 2; ++bj)
#pragma unroll
                    for (int n = 0; n < 2; ++n) { const f32x4 v = acc[ai][bj][m][n]; u32x2 w; w.x = pk2(v[0], v[1]); w.y = pk2(v[2], v[3]); *(u32x2*)(rowp + bj * 128 + n * 16) = w; } }
    } };
struct EpiGLU { static constexpr bool PERM = false, AFTER_DRAIN = false; const bf16_t* G; bf16_t* Y; const float* bias;
    DI void operator()(AccT acc, const pg8::Unit& u, int wr, int wc, int fr, int fq) const {
        const int row0 = u.pm * 256 + wr * 64 + fr, col0 = u.pn * 256 + wc * 32 + 4 * fq;
#pragma unroll
        for (int ai = 0; ai < 2; ++ai)
#pragma unroll
            for (int m = 0; m < 4; ++m) { const size_t off = (size_t)(row0 + ai * 128 + m * 16) * ABW + col0;
#pragma unroll
                for (int bj = 0; bj < 2; ++bj)
#pragma unroll
                    for (int n = 0; n < 2; ++n) { const int cc = bj * 128 + n * 16; const f32x4 v = acc[ai][bj][m][n]; const f32x4 bv = *(const f32x4*)(bias + col0 + cc);
                        const u32x2 g = *(const u32x2*)(G + off + cc); u32x2 w;
                        w.x = pk2(bflo(g.x) * sigm(v[0] + bv[0]), bfhi(g.x) * sigm(v[1] + bv[1])); w.y = pk2(bflo(g.y) * sigm(v[2] + bv[2]), bfhi(g.y) * sigm(v[3] + bv[3]));
                        *(u32x2*)(Y + off + cc) = w; } }
    } };
struct EpiF32 { static constexpr bool PERM = false, AFTER_DRAIN = false; float* C;
    DI void operator()(AccT acc, const pg8::Unit& u, int wr, int wc, int fr, int fq) const {
        const int row0 = u.pm * 256 + wr * 64 + fr, col0 = u.pn * 256 + wc * 32 + 4 * fq;
#pragma unroll
        for (int ai = 0; ai < 2; ++ai)
#pragma unroll
            for (int m = 0; m < 4; ++m) { const size_t off = (size_t)(row0 + ai * 128 + m * 16) * D_ + col0;
#pragma unroll
                for (int bj = 0; bj < 2; ++bj)
#pragma unroll
                    for (int n = 0; n < 2; ++n) *(f32x4*)(C + off + bj * 128 + n * 16) = acc[ai][bj][m][n]; }
    } };
struct EpiPLE { static constexpr bool PERM = false, AFTER_DRAIN = false; float* X; const float* PP; bf16_t* XB;
    DI void operator()(AccT acc, const pg8::Unit& u, int wr, int wc, int fr, int fq) const {
        const int row0 = u.pm * 256 + wr * 64 + fr, col0 = u.pn * 256 + wc * 32 + 4 * fq;
#pragma unroll
        for (int ai = 0; ai < 2; ++ai)
#pragma unroll
            for (int m = 0; m < 4; ++m) { const size_t off = (size_t)(row0 + ai * 128 + m * 16) * D_ + col0;
#pragma unroll
                for (int bj = 0; bj < 2; ++bj)
#pragma unroll
                    for (int n = 0; n < 2; ++n) { const size_t o = off + bj * 128 + n * 16; const f32x4 a = acc[ai][bj][m][n]; const f32x4 x = *(const f32x4*)(X + o), pp = *(const f32x4*)(PP + o); f32x4 r;
#pragma unroll
                        for (int j = 0; j < 4; ++j) r[j] = x[j] + sigm(a[j]) * pp[j];
                        *(f32x4*)(X + o) = r; u32x2 w; w.x = pk2(r[0], r[1]); w.y = pk2(r[2], r[3]); *(u32x2*)(XB + o) = w; } }
    } };

template <class Epi> DI void run_gemm(LAS unsigned char* lds, const bf16_t* A, int lda, const bf16_t* Bt, int N, int K, const Epi& E) {
    pg8::Gemm g{A, Bt, T_, N, K, lda}; pg8::StaticOrder S; S.init(T_, N, (int)gridDim.x, (int)blockIdx.x);
    pg8::gemm_phase<Epi, pg8::StaticOrder, false>(lds, g, S, E, nullptr);
}
#define XB_TMO      128
#define XB_XCNT(j)  (256  + 64 * (j))
#define XB_XSUB(j)  (1280 + 64 * (j))
#define XB_XGEN(j)  (2304 + 64 * (j))
#define XB_TOP      3328
#define XB_TOPGEN   3392
#define XCD_BAR_WORDS 3456
#define XB_SPIN_CAP (1u << 18)

__device__ __forceinline__ unsigned xb_ld(unsigned* p)              { return __hip_atomic_load(p, __ATOMIC_RELAXED, __HIP_MEMORY_SCOPE_AGENT); }
__device__ __forceinline__ unsigned xb_add(unsigned* p, unsigned v) { return __hip_atomic_fetch_add(p, v, __ATOMIC_RELAXED, __HIP_MEMORY_SCOPE_AGENT); }
__device__ __forceinline__ unsigned xb_xcc_id() { return (unsigned)__builtin_amdgcn_s_getreg((3 << 11) | 20) & 0xFu; }
#define XB_SPIN(cond, bar) do { unsigned _sp = 0; while (cond) { __builtin_amdgcn_s_sleep(1); \
    if ((++_sp & 255u) == 0u) { if (xb_ld(&(bar)[XB_TMO])) break; if (_sp > XB_SPIN_CAP) { atomicAdd(&(bar)[XB_TMO], 1u); break; } } } } while (0)

struct XcdBarrier {
    unsigned* bar; unsigned x;
    volatile LAS unsigned* st;
};

__device__ __forceinline__ XcdBarrier xcd_barrier_post(unsigned* bar, volatile LAS unsigned* st) {
    XcdBarrier b; b.bar = bar; b.x = xb_xcc_id(); b.st = st;
    if (threadIdx.x == 0) (void)xb_add(&bar[XB_XCNT(b.x)], 1u);
    return b;
}
__device__ __forceinline__ void xcd_barrier_complete(unsigned* bar, unsigned x, unsigned& nloc, unsigned& nx) {
    const unsigned G = gridDim.x * gridDim.y * gridDim.z;
    unsigned sum, cnt, mine, sp = 0u;
    for (;;) {
        sum = 0u; cnt = 0u; mine = 0u;
#pragma unroll
        for (unsigned j = 0; j < 16; ++j) { const unsigned c = xb_ld(&bar[XB_XCNT(j)]); sum += c; cnt += (c > 0u) ? 1u : 0u; mine = (j == x) ? c : mine; }
        if (sum == G) break;
        __builtin_amdgcn_s_sleep(1);
        if ((++sp & 255u) == 0u) { if (xb_ld(&bar[XB_TMO])) break; if (sp > XB_SPIN_CAP) { atomicAdd(&bar[XB_TMO], 1u); break; } }
    }
    nloc = mine > 0u ? mine : 1u; nx = cnt > 0u ? cnt : 1u;
}

__device__ __forceinline__ void xcd_barrier(const XcdBarrier& b) {
    asm volatile("s_waitcnt vmcnt(0)" ::: "memory");
    __syncthreads();
    if (threadIdx.x == 0) {
        unsigned* bar = b.bar;
        __builtin_amdgcn_s_waitcnt(0);
        unsigned nloc = b.st[0], nx = b.st[1];
        if (nloc == 0u) { xcd_barrier_complete(bar, b.x, nloc, nx); b.st[0] = nloc; b.st[1] = nx; }
        const unsigned old = xb_add(&bar[XB_XSUB(b.x)], 1u);
        const unsigned gen = old / nloc;
        if (old + 1u == (gen + 1u) * nloc) {
            __builtin_amdgcn_fence(__ATOMIC_RELEASE, "agent");
            asm volatile("s_waitcnt vmcnt(0)" ::: "memory");
            const unsigned og = xb_add(&bar[XB_TOP], 1u);
            const unsigned tg = og / nx;
            if (og + 1u == (tg + 1u) * nx) xb_add(&bar[XB_TOPGEN], 1u);
            else XB_SPIN(xb_ld(&bar[XB_TOPGEN]) == tg, bar);
            __builtin_amdgcn_fence(__ATOMIC_ACQUIRE, "agent");
            xb_add(&bar[XB_XGEN(b.x)], 1u);
            asm volatile("s_waitcnt vmcnt(0)" ::: "memory");
        } else {
            XB_SPIN(xb_ld(&bar[XB_XGEN(b.x)]) == gen, bar);
            __builtin_amdgcn_fence(__ATOMIC_ACQUIRE, "agent");
            asm volatile("s_waitcnt vmcnt(0)" ::: "memory");
        }
    }
    __syncthreads();
}
struct Job { const float* src; bf16_t* dst; int K, N, map; };
DI int mapn(int map, int n) {
    if (map == 0) return n;
    if (map == 1) return 256 * (n >> 7) + (n & 127);
    if (map == 2) return 256 * (n >> 7) + 128 + (n & 127);
    if (map == 3) return n < 3072 ? n : (n < 3088 ? n + 1024 : n - 16);
    return n < 1536 ? n + 1024 : (n < 2048 ? n - 1536 : (n < 3088 ? n + 512 : n - 2576));
}
DI Job get_job(const Params& P, int j) {
    unsigned char* ws = P.ws; Job J;
    if (j < 4)       { J.src = P.in[4] + (size_t)j * 1024 * 2816;        J.dst = (bf16_t*)(ws + OFF_WGU + j * SZ_WGU);        J.K = 1024; J.N = 2816; J.map = 1; }
    else if (j < 8)  { J.src = P.in[5] + (size_t)(j - 4) * 1024 * 2816;  J.dst = (bf16_t*)(ws + OFF_WGU + (j - 4) * SZ_WGU);  J.K = 1024; J.N = 2816; J.map = 2; }
    else if (j < 12) { J.src = P.in[6] + (size_t)(j - 8) * 2816 * 1024;  J.dst = (bf16_t*)(ws + OFF_WD + (j - 8) * SZ_WD);    J.K = 2816; J.N = 1024; J.map = 0; }
    else if (j < 14) { J.src = P.in[7] + (size_t)(j - 12) * 1024 * 1024; J.dst = (bf16_t*)(ws + OFF_WPG + (j - 12) * SZ_W1K); J.K = 1024; J.N = 1024; J.map = 0; }
    else if (j < 16) { J.src = P.in[8] + (size_t)(j - 14) * 256 * 1024;  J.dst = (bf16_t*)(ws + OFF_WPP + (j - 14) * SZ_WPP); J.K = 256;  J.N = 1024; J.map = 0; }
    else if (j == 16) { J.src = P.in[9];  J.dst = (bf16_t*)(ws + OFF_WABIN);  J.K = 1024; J.N = 4112; J.map = 3; }
    else if (j == 17) { J.src = P.in[10]; J.dst = (bf16_t*)(ws + OFF_WABOUT); J.K = 2048; J.N = 1024; J.map = 0; }
    else if (j == 18) { J.src = P.in[25]; J.dst = (bf16_t*)(ws + OFF_WGLU);   J.K = 1024; J.N = 1024; J.map = 0; }
    else if (j == 19) { J.src = P.in[27]; J.dst = (bf16_t*)(ws + OFF_WCDIN);  J.K = 1024; J.N = 3600; J.map = 4; }
    else              { J.src = P.in[28]; J.dst = (bf16_t*)(ws + OFF_WCDOUT); J.K = 1024; J.N = 1024; J.map = 0; }
    return J;
}
DI void convT_tile(LAS bf16_t* tl, const Job& J, int tile) {
    const int ntn = (J.N + 63) >> 6, tk = tile / ntn, tn = tile - tk * ntn, k0 = tk * 64, n0 = tn * 64, tid = otid();
    const int n4 = (tid & 15) * 4, kr = tid >> 4;
    if (n0 + n4 < J.N) {
#pragma unroll
        for (int ps = 0; ps < 2; ++ps) { const int k = kr + 32 * ps; const f32x4 v = *(const f32x4*)(J.src + (size_t)(k0 + k) * J.N + n0 + n4);
#pragma unroll
            for (int i = 0; i < 4; ++i) tl[(n4 + i) * 72 + k] = f2bf(v[i]); }
    }
    __syncthreads();
    const int n = tid >> 3, kg = tid & 7;
    if (n0 + n < J.N) { const u32x4 w = *(const LAS u32x4*)(tl + n * 72 + kg * 8); *(u32x4*)(J.dst + (size_t)mapn(J.map, n0 + n) * J.K + k0 + kg * 8) = w; }
    __syncthreads();
}
DI void sincos_d(double x, double& s, double& c) {
    const double kq = rint(x * 0.63661977236758134308); const double r = x - kq * 1.57079632679489661923; const double r2 = r * r;
    const double sr = r * (1.0 - r2 / 6.0 * (1.0 - r2 / 20.0 * (1.0 - r2 / 42.0 * (1.0 - r2 / 72.0 * (1.0 - r2 / 110.0 * (1.0 - r2 / 156.0 * (1.0 - r2 / 210.0)))))));
    const double cr = 1.0 - r2 / 2.0 * (1.0 - r2 / 12.0 * (1.0 - r2 / 30.0 * (1.0 - r2 / 56.0 * (1.0 - r2 / 90.0 * (1.0 - r2 / 132.0 * (1.0 - r2 / 182.0 * (1.0 - r2 / 240.0)))))));
    const int qd = ((int)kq) & 3;
    s = qd == 0 ? sr : (qd == 1 ? cr : (qd == 2 ? -sr : -cr)); c = qd == 0 ? cr : (qd == 1 ? -sr : (qd == 2 ? -cr : sr));
}
DI double exp_d(double x) { const double y = x * 0.015625; double e = 1.0 + y * (1.0 + y / 2.0 * (1.0 + y / 3.0 * (1.0 + y / 4.0 * (1.0 + y / 5.0 * (1.0 + y / 6.0 * (1.0 + y / 7.0 * (1.0 + y / 8.0 * (1.0 + y / 9.0 * (1.0 + y / 10.0))))))))); e *= e; e *= e; e *= e; e *= e; e *= e; e *= e; return e; }
DI void p0_phase(const Params& P, LAS unsigned char* lds) {
    const int tid = otid(), G = gridDim.x, bid = blockIdx.x;
    {
        int base = 0;
        for (int j = 0; j < 21; ++j) { const Job J = get_job(P, j); const int nt = (J.K >> 6) * ((J.N + 63) >> 6);
            int first = (bid - base % G + G) % G;
            for (int t = first; t < nt; t += G) convT_tile((LAS bf16_t*)lds, J, t);
            base += nt; }
    }
    const size_t gt = (size_t)bid * 512 + tid, gs = (size_t)G * 512;
    { u32x4 z = {0u, 0u, 0u, 0u}; u32x4* a = (u32x4*)(P.ws + OFF_WABIN + (size_t)4112 * 1024 * 2); for (size_t i = gt; i < (size_t)240 * 1024 * 2 / 16; i += gs) a[i] = z;
      u32x4* c = (u32x4*)(P.ws + OFF_WCDIN + (size_t)3600 * 1024 * 2); for (size_t i = gt; i < (size_t)240 * 1024 * 2 / 16; i += gs) c[i] = z; }
    { const f32x4* x = (const f32x4*)P.in[0]; u32x2* xb = (u32x2*)(P.ws + OFF_XB); for (size_t i = gt; i < (size_t)T_ * D_ / 4; i += gs) { const f32x4 v = x[i]; u32x2 w; w.x = pk2(v[0], v[1]); w.y = pk2(v[2], v[3]); xb[i] = w; } }
    for (size_t i = gt; i < 64 * 64; i += gs) { const int g = (int)(i >> 6), n = (int)(i & 63);
        const double dt = exp_d((double)P.in[19][g]);
        const double lr = (double)P.in[17][i], li = (double)P.in[18][i];
        const double e = exp_d(lr * dt); double sn, cs; sincos_d(li * dt, sn, cs); const double lbr = e * cs, lbi = e * sn;
        const double den = lr * lr + li * li, cr = ((lbr - 1.0) * lr + lbi * li) / den, ci = (lbi * lr - (lbr - 1.0) * li) / den;
        float* lt = (float*)(P.ws + OFF_S5L); lt[i * 2] = (float)lbr; lt[i * 2 + 1] = (float)lbi;
        float* bt = (float*)(P.ws + OFF_S5B) + (size_t)g * 128 * 16;
        for (int q = 0; q < 16; ++q) { const double br = (double)P.in[20][i * 16 + q], bi = (double)P.in[21][i * 16 + q]; bt[n * 16 + q] = (float)(cr * br - ci * bi); bt[(64 + n) * 16 + q] = (float)(cr * bi + ci * br); } }
}
DI float wave_sum(float v) { v += __shfl_xor(v, 32); v += __shfl_xor(v, 16); v += __shfl_xor(v, 8); v += __shfl_xor(v, 4); v += __shfl_xor(v, 2); v += __shfl_xor(v, 1); return v; }
DI void ln_phase(float* X, bf16_t* XB, const float* g, const float* b) {
    const int wave = otid() >> 6, lane = otid() & 63;
    for (int row = blockIdx.x * 8 + wave; row < T_; row += gridDim.x * 8) {
        float* r = X + (size_t)row * D_; f32x4 v[4]; float s = 0.f;
#pragma unroll
        for (int i = 0; i < 4; ++i) { v[i] = *(const f32x4*)(r + i * 256 + lane * 4); s += (v[i][0] + v[i][1]) + (v[i][2] + v[i][3]); }
        const float mean = wave_sum(s) * (1.f / 1024.f); float q = 0.f;
#pragma unroll
        for (int i = 0; i < 4; ++i) { v[i] = v[i] - mean; q += (v[i][0] * v[i][0] + v[i][1] * v[i][1]) + (v[i][2] * v[i][2] + v[i][3] * v[i][3]); }
        const float rstd = 1.0f / sqrtf(wave_sum(q) * (1.f / 1024.f) + EPS_);
#pragma unroll
        for (int i = 0; i < 4; ++i) { const f32x4 gg = *(const f32x4*)(g + i * 256 + lane * 4), bb = *(const f32x4*)(b + i * 256 + lane * 4); const f32x4 o = v[i] * rstd * gg + bb;
            *(f32x4*)(r + i * 256 + lane * 4) = o; u32x2 w; w.x = pk2(o[0], o[1]); w.y = pk2(o[2], o[3]); *(u32x2*)(XB + (size_t)row * D_ + i * 256 + lane * 4) = w; }
    }
}
DI void p_to_bf16(const float* p, bf16_t* pb) {
    const size_t gt = (size_t)blockIdx.x * 512 + otid(), gs = (size_t)gridDim.x * 512;
    for (size_t i = gt; i < (size_t)T_ * 256 / 4; i += gs) { const f32x4 v = ((const f32x4*)p)[i]; u32x2 w; w.x = pk2(v[0], v[1]); w.y = pk2(v[2], v[3]); ((u32x2*)pb)[i] = w; }
}
DI void ssd_rms_phase(bf16_t* BIG, const float* nw) {
    const int wave = otid() >> 6, lane = otid() & 63;
    for (int row = blockIdx.x * 8 + wave; row < T_; row += gridDim.x * 8) {
        bf16_t* r = BIG + (size_t)row * ABW + lane * 16; const u32x4 a = *(const u32x4*)r, c = *(const u32x4*)(r + 8);
        float v[16]; v[0] = bflo(a.x); v[1] = bfhi(a.x); v[2] = bflo(a.y); v[3] = bfhi(a.y); v[4] = bflo(a.z); v[5] = bfhi(a.z); v[6] = bflo(a.w); v[7] = bfhi(a.w);
        v[8] = bflo(c.x); v[9] = bfhi(c.x); v[10] = bflo(c.y); v[11] = bfhi(c.y); v[12] = bflo(c.z); v[13] = bfhi(c.z); v[14] = bflo(c.w); v[15] = bfhi(c.w);
        float s = 0.f;
#pragma unroll
        for (int i = 0; i < 16; ++i) s += v[i] * v[i];
        s += __shfl_xor(s, 8); s += __shfl_xor(s, 4); s += __shfl_xor(s, 2); s += __shfl_xor(s, 1);
        const float rstd = 1.0f / sqrtf(s * (1.f / 256.f) + EPS_);
        const float* w = nw + lane * 16; u32x4 o0, o1;
        o0.x = pk2(v[0] * rstd * w[0], v[1] * rstd * w[1]); o0.y = pk2(v[2] * rstd * w[2], v[3] * rstd * w[3]); o0.z = pk2(v[4] * rstd * w[4], v[5] * rstd * w[5]); o0.w = pk2(v[6] * rstd * w[6], v[7] * rstd * w[7]);
        o1.x = pk2(v[8] * rstd * w[8], v[9] * rstd * w[9]); o1.y = pk2(v[10] * rstd * w[10], v[11] * rstd * w[11]); o1.z = pk2(v[12] * rstd * w[12], v[13] * rstd * w[13]); o1.w = pk2(v[14] * rstd * w[14], v[15] * rstd * w[15]);
        *(u32x4*)r = o0; *(u32x4*)(r + 8) = o1;
    }
}
template <int KIND> struct Cfg;
template <> struct Cfg<0> { static constexpr int DK = 128, DV = 64, LD = ABW; };
template <> struct Cfg<1> { static constexpr int DK = 128, DV = 128, LD = CDW; };
template <> struct Cfg<2> { static constexpr int DK = 64, DV = 128, LD = CDW; };
#define MFMA16(a, b, c) __builtin_amdgcn_mfma_f32_16x16x32_bf16((a), (b), (c), 0, 0, 0)
#define FRAG(off, row, pitch) (*(const LAS bf16x8*)(lds + (off) + (row) * (pitch) + kb0))
#define ST16(off, val) (*(LAS bf16_t*)(lds + (off)) = (val))

template <int KIND, int MODE, int NS>
DI void cla_item(const Params& P, LAS unsigned char* lds, const int b, const int h, const int seg, float* stbase) {
    constexpr int DK = Cfg<KIND>::DK, DV = Cfg<KIND>::DV, LD = Cfg<KIND>::LD;
    constexpr int PQB = (DK + 8) * 2, P64B = 144;
    constexpr int oQs = 0, oKs = oQs + 64 * PQB, oKh = oKs + 64 * PQB, oVt = oKh + DK * P64B, oST = oVt + DV * P64B, oAt = oST + DV * PQB, oXs = oAt + 64 * P64B,
                  oTot = oXs + 64 * P64B, oEgm = oTot + 8 * 128 * 4, oEgl = oEgm + 512, oAc = oEgl + 512, oRed = oAc + 256;
    static_assert(oRed + 512 <= LDS_BYTES, "cla LDS");
    constexpr int NDT = DK / 16, WPD = 8 / NDT, NVT = DV / 16, NT = NVT / WPD, NVW = DV / 32, KS = DK / 32;
    const int tid = otid(), lane = tid & 63, w = __builtin_amdgcn_readfirstlane(tid >> 6), r16 = lane & 15, q4 = lane >> 4;
    const int lt = w >> 1, wh = w & 1, dti = w / WPD, vt0 = (w % WPD) * NT;
    bf16_t* BIG = (bf16_t*)(P.ws + OFF_BIG) + (size_t)b * L_ * LD;
    LAS float* tot = (LAS float*)(lds + oTot); LAS float* egm = (LAS float*)(lds + oEgm); LAS float* egl = (LAS float*)(lds + oEgl);
    LAS float* acum = (LAS float*)(lds + oAc); LAS float* red = (LAS float*)(lds + oRed);
    f32x4 accS[NT];
#pragma unroll
    for (int i = 0; i < NT; ++i) accS[i] = (f32x4){0.f, 0.f, 0.f, 0.f};
    constexpr int REC = DK * DV + 128;
    float gsum = 0.f;
    if constexpr (MODE == 1) {
        for (int j = 0; j < seg; ++j) { const float* rec = stbase + (size_t)j * REC; const int d0 = 16 * dti + 4 * q4;
            f32x4 e; if constexpr (KIND == 0) { const float e0 = __expf(rec[DK * DV]); e = (f32x4){e0, e0, e0, e0}; } else { const f32x4 gs = *(const f32x4*)(rec + DK * DV + d0); e = (f32x4){__expf(gs[0]), __expf(gs[1]), __expf(gs[2]), __expf(gs[3])}; }
#pragma unroll
            for (int i = 0; i < NT; ++i) accS[i] = accS[i] * e + *(const f32x4*)(rec + ((size_t)(w * NT + i) * 64 + lane) * 4); }
    }
    float c_lb = 0.f, c_bg = 0.f, c_Ah = 0.f, c_dtb = 0.f, c_Dh = 0.f; float wup[16];
#pragma unroll
    for (int r = 0; r < 16; ++r) wup[r] = 0.f;
    if constexpr (KIND == 0) { c_Ah = -__expf(P.in[14][h]); c_dtb = P.in[13][h]; c_Dh = P.in[15][h]; }
    if constexpr (KIND == 1) { const int d = tid & 127; c_lb = sigm(P.in[29][512 + h * 128 + d] - P.in[29][h * 128 + d]); }
    if constexpr (KIND == 2) { const int d = tid & 63; c_bg = P.in[32][h * 64 + d];
#pragma unroll
        for (int r = 0; r < 16; ++r) wup[r] = P.in[31][r * 256 + h * 64 + d]; }

    typedef const __attribute__((address_space(1))) bf16_t* gbf;
    typedef const __attribute__((address_space(1))) unsigned* gu32p;
    const gbf BG = (gbf)BIG;
    bf16_t rA[19], rB[19], rC[16]; bf16_t rD[8]; bf16_t rE = 0; unsigned rG = 0u;
#pragma unroll
    for (int i = 0; i < 19; ++i) { rA[i] = 0; rB[i] = 0; }
#pragma unroll
    for (int i = 0; i < 16; ++i) rC[i] = 0;
#pragma unroll
    for (int i = 0; i < 8; ++i) rD[i] = 0;
#define LOAD_RAW(cc) do { const int t0n = (cc) * 64; \
        if constexpr (KIND == 0) { const int g = h >> 2; const int ch = tid & 127, tg = tid >> 7, ts = t0n + tg * 16; \
            const gbf sb = BG + (size_t)ts * LD + 2048 + g * 128 + ch; const gbf sc = sb + 512; \
            if (ts > 0) { _Pragma("unroll") for (int i = 0; i < 3; ++i) { rA[i] = sb[(i - 3) * LD]; if constexpr (MODE == 1) rB[i] = sc[(i - 3) * LD]; } } else { _Pragma("unroll") for (int i = 0; i < 3; ++i) { rA[i] = 0; rB[i] = 0; } } \
            _Pragma("unroll") for (int i = 0; i < 16; ++i) { rA[3 + i] = sb[i * LD]; if constexpr (MODE == 1) rB[3 + i] = sc[i * LD]; } \
            const int p = tid & 63, tg2 = tid >> 6, ts2 = t0n + tg2 * 8; const gbf sx = BG + (size_t)ts2 * LD + 1024 + h * 64 + p; const gbf sd = BG + (size_t)ts2 * LD + 4096 + h; \
            if (ts2 > 0) { _Pragma("unroll") for (int i = 0; i < 3; ++i) rC[i] = sx[(i - 3) * LD]; } else { _Pragma("unroll") for (int i = 0; i < 3; ++i) rC[i] = 0; } \
            _Pragma("unroll") for (int i = 0; i < 8; ++i) { rC[3 + i] = sx[i * LD]; rD[i] = sd[i * LD]; } \
            if (w == 0) rE = BG[(size_t)(t0n + lane) * LD + 4096 + h]; } \
        if constexpr (KIND == 1) { const int d = tid & 127, tg = tid >> 7; const gbf sp = BG + (size_t)(t0n + tg * 16) * LD + h * 128 + d; \
            _Pragma("unroll") for (int i = 0; i < 16; ++i) { if constexpr (MODE == 1) rA[i] = sp[i * LD + 1024]; rB[i] = sp[i * LD + 1536]; rC[i] = sp[i * LD + 2048]; } } \
        if constexpr (KIND == 2) { const int d = tid & 63, tg = tid >> 6; const gbf sp = BG + (size_t)(t0n + tg * 8) * LD + h * 64 + d; \
            _Pragma("unroll") for (int i = 0; i < 8; ++i) { if constexpr (MODE == 1) rA[i] = sp[i * LD + 2560]; rB[i] = sp[i * LD + 2816]; } \
            const int v = tid & 127, tgv = tid >> 7; const gbf sv = BG + (size_t)(t0n + tgv * 16) * LD + 3072 + h * 128 + v; \
            _Pragma("unroll") for (int i = 0; i < 16; ++i) rC[i] = sv[i * LD]; \
            rG = *(gu32p)(BG + (size_t)(t0n + (tid >> 3)) * LD + 3584 + 2 * (tid & 7)); } \
    } while (0)
#define BAR_LDS() do { asm volatile("s_waitcnt lgkmcnt(0)" ::: "memory"); __builtin_amdgcn_s_barrier(); asm volatile("" ::: "memory"); } while (0)
    constexpr int CPS = 64 / NS;
    LOAD_RAW(seg * CPS);
    for (int c = seg * CPS; c < (seg + 1) * CPS; ++c) {
        const int t0 = c * 64;
        float eglS = 1.f;
        if constexpr (KIND == 0) {
            const int g = h >> 2; const float* cw = P.in[11]; const float* cb = P.in[12];
            const int ch = tid & 127, tg = tid >> 7;
            float breg[16];
            { const int cc = 1024 + g * 128 + ch; const float w0 = cw[cc], w1 = cw[2048 + cc], w2 = cw[4096 + cc], w3 = cw[6144 + cc], bb = cb[cc];
#pragma unroll
              for (int i = 0; i < 16; ++i) { const float v = silu(w0 * bf2f(rA[i]) + w1 * bf2f(rA[i + 1]) + w2 * bf2f(rA[i + 2]) + w3 * bf2f(rA[i + 3]) + bb);
                  if constexpr (MODE == 1) ST16(oKs + (tg * 16 + i) * PQB + ch * 2, f2bf(v)); breg[i] = v; } }
            if constexpr (MODE == 1) { const int cc = 1536 + g * 128 + ch; const float w0 = cw[cc], w1 = cw[2048 + cc], w2 = cw[4096 + cc], w3 = cw[6144 + cc], bb = cb[cc];
#pragma unroll
              for (int i = 0; i < 16; ++i) { const float v = silu(w0 * bf2f(rB[i]) + w1 * bf2f(rB[i + 1]) + w2 * bf2f(rB[i + 2]) + w3 * bf2f(rB[i + 3]) + bb);
                  ST16(oQs + (tg * 16 + i) * PQB + ch * 2, f2bf(v)); } }
            {
                const int p = tid & 63, tg2 = tid >> 6, cc = h * 64 + p;
                const float w0 = cw[cc], w1 = cw[2048 + cc], w2 = cw[4096 + cc], w3 = cw[6144 + cc], bb = cb[cc];
#pragma unroll
                for (int i = 0; i < 8; ++i) { const float v = silu(w0 * bf2f(rC[i]) + w1 * bf2f(rC[i + 1]) + w2 * bf2f(rC[i + 2]) + w3 * bf2f(rC[i + 3]) + bb);
                    const float dtv = softplus(bf2f(rD[i]) + c_dtb);
                    ST16(oVt + p * P64B + (tg2 * 8 + i) * 2, f2bf(v * dtv)); if constexpr (MODE == 1) ST16(oXs + (tg2 * 8 + i) * P64B + p * 2, f2bf(v)); }
            }
            if (w == 0) { float a = softplus(bf2f(rE) + c_dtb) * c_Ah;
#pragma unroll
                for (int o = 1; o < 64; o <<= 1) { const float t = __shfl_up(a, o); if (lane >= o) a += t; }
                acum[lane] = a; }
            BAR_LDS();
            const float alast = acum[63]; eglS = __expf(alast); gsum += alast;
#pragma unroll
            for (int i = 0; i < 16; ++i) ST16(oKh + ch * P64B + (tg * 16 + i) * 2, f2bf(breg[i] * __expf(alast - acum[tg * 16 + i])));
        }
        if constexpr (KIND == 1) {
            const int d = tid & 127, tg = tid >> 7;
            float qv[16], kv[16], cv[16]; float cum = 0.f;
#pragma unroll
            for (int i = 0; i < 16; ++i) { const float fl = bf2f(rB[i]);
                const float kk = (1.f - c_lb) * sigm(-fl); cum += __logf(1.f - kk); if constexpr (MODE == 1) qv[i] = silu(bf2f(rA[i])); kv[i] = kk; cv[i] = cum; ST16(oVt + d * P64B + (tg * 16 + i) * 2, rC[i]); }
            tot[tg * 128 + d] = cum;
            BAR_LDS();
            const float t0v = tot[d], t1v = tot[128 + d], t2v = tot[256 + d], t3v = tot[384 + d];
            const float off = (tg > 0 ? t0v : 0.f) + (tg > 1 ? t1v : 0.f) + (tg > 2 ? t2v : 0.f), gm = t0v + t1v, gl = gm + t2v + t3v;
#pragma unroll
            for (int i = 0; i < 16; ++i) { const float g = off + cv[i]; const int tl = tg * 16 + i;
                if constexpr (MODE == 1) { ST16(oQs + tl * PQB + d * 2, f2bf(qv[i] * __expf(g - gm))); ST16(oKs + tl * PQB + d * 2, f2bf(kv[i] * __expf(gm - g))); }
                ST16(oKh + d * P64B + tl * 2, f2bf(kv[i] * __expf(gl - g))); }
            if (tg == 0) { egm[d] = __expf(gm); egl[d] = __expf(gl); gsum += gl; }
        }
        if constexpr (KIND == 2) {
            const int d = tid & 63, tg = tid >> 6;
            LAS unsigned* glrS = (LAS unsigned*)(lds + oXs);
            glrS[tid] = rG;
            { const int v = tid & 127, tgv = tid >> 7;
#pragma unroll
                for (int i = 0; i < 16; ++i) ST16(oVt + v * P64B + (tgv * 16 + i) * 2, rC[i]); }
            BAR_LDS();
            float qv[8], kv[8], cv[8]; float cum = 0.f;
#pragma unroll
            for (int i = 0; i < 8; ++i) { const u32x4 ga = *(const LAS u32x4*)(glrS + (tg * 8 + i) * 8), gb = *(const LAS u32x4*)(glrS + (tg * 8 + i) * 8 + 4);
                float lg = c_bg;
                lg += bflo(ga.x) * wup[0] + bfhi(ga.x) * wup[1] + bflo(ga.y) * wup[2] + bfhi(ga.y) * wup[3] + bflo(ga.z) * wup[4] + bfhi(ga.z) * wup[5] + bflo(ga.w) * wup[6] + bfhi(ga.w) * wup[7];
                lg += bflo(gb.x) * wup[8] + bfhi(gb.x) * wup[9] + bflo(gb.y) * wup[10] + bfhi(gb.y) * wup[11] + bflo(gb.z) * wup[12] + bfhi(gb.z) * wup[13] + bflo(gb.w) * wup[14] + bfhi(gb.w) * wup[15];
                cum += logsigm(lg) * 0.0625f; if constexpr (MODE == 1) qv[i] = bf2f(rA[i]) * 0.125f; kv[i] = bf2f(rB[i]); cv[i] = cum; }
            tot[tg * 128 + d] = cum;
            BAR_LDS();
            float off = 0.f, gm = 0.f, gl = 0.f;
#pragma unroll
            for (int g2 = 0; g2 < 8; ++g2) { const float tv = tot[g2 * 128 + d]; if (g2 < tg) off += tv; if (g2 < 4) gm += tv; gl += tv; }
#pragma unroll
            for (int i = 0; i < 8; ++i) { const float g = off + cv[i]; const int tl = tg * 8 + i;
                if constexpr (MODE == 1) { ST16(oQs + tl * PQB + d * 2, f2bf(qv[i] * __expf(g - gm))); ST16(oKs + tl * PQB + d * 2, f2bf(kv[i] * __expf(gm - g))); }
                ST16(oKh + d * P64B + tl * 2, f2bf(kv[i] * __expf(gl - g))); }
            if (tg == 0) { egm[d] = __expf(gm); egl[d] = __expf(gl); gsum += gl; }
        }
        if (c + 1 < (seg + 1) * CPS) LOAD_RAW(c + 1);
        BAR_LDS();
        f32x4 accO[NVW]; const int lrow = 16 * lt + r16;
        if constexpr (MODE == 1) {
#pragma unroll
        for (int i = 0; i < NT; ++i) { const int v = 16 * (vt0 + i) + r16, d0 = 16 * dti + 4 * q4; f32x4 s = accS[i];
            if constexpr (KIND != 0) { const f32x4 e = *(const LAS f32x4*)(egm + d0); s = s * e; }
            u32x2 wv; wv.x = pk2(s[0], s[1]); wv.y = pk2(s[2], s[3]); *(LAS u32x2*)(lds + oST + v * PQB + d0 * 2) = wv; }
#pragma unroll
        for (int e = 0; e < 2; ++e) { const int st = 2 * wh + e; f32x4 a = {0.f, 0.f, 0.f, 0.f};
            if (st <= lt) {
#pragma unroll
                for (int ks = 0; ks < KS; ++ks) { const int kb0 = ks * 64 + q4 * 16; a = MFMA16(FRAG(oKs, 16 * st + r16, PQB), FRAG(oQs, 16 * lt + r16, PQB), a); }
                const int l = 16 * lt + r16, s0 = 16 * st + 4 * q4;
#pragma unroll
                for (int j = 0; j < 4; ++j) { float dec = 1.f; if constexpr (KIND == 0) dec = __expf(fminf(acum[l] - acum[s0 + j], 0.f)); a[j] = (s0 + j <= l) ? a[j] * dec : 0.f; }
            }
            u32x2 wv; wv.x = pk2(a[0], a[1]); wv.y = pk2(a[2], a[3]); *(LAS u32x2*)(lds + oAt + (16 * lt + r16) * P64B + (16 * st + 4 * q4) * 2) = wv; }
        BAR_LDS();
        {
            bf16x8 qf[KS];
#pragma unroll
            for (int ks = 0; ks < KS; ++ks) { const int kb0 = ks * 64 + q4 * 16; qf[ks] = FRAG(oQs, 16 * lt + r16, PQB); }
#pragma unroll
            for (int i = 0; i < NVW; ++i) { const int vt = wh * NVW + i; f32x4 a = {0.f, 0.f, 0.f, 0.f};
#pragma unroll
                for (int ks = 0; ks < KS; ++ks) { const int kb0 = ks * 64 + q4 * 16; a = MFMA16(FRAG(oST, 16 * vt + r16, PQB), qf[ks], a); }
                if constexpr (KIND == 0) a = a * __expf(acum[16 * lt + r16]);
                accO[i] = a; }
#pragma unroll
            for (int ks = 0; ks < 2; ++ks) { if (ks * 32 <= 16 * lt + 15) { const int kb0 = ks * 64 + q4 * 16; const bf16x8 af = FRAG(oAt, 16 * lt + r16, P64B);
#pragma unroll
                for (int i = 0; i < NVW; ++i) accO[i] = MFMA16(FRAG(oVt, 16 * (wh * NVW + i) + r16, P64B), af, accO[i]); } }
        }
        if constexpr (KIND == 0) {
#pragma unroll
            for (int i = 0; i < NVW; ++i) { const int p0 = 16 * (wh * NVW + i) + 4 * q4; bf16_t* zp = BIG + (size_t)(t0 + lrow) * LD + h * 64 + p0;
                const u32x2 z = *(const u32x2*)zp; const u32x2 xs = *(const LAS u32x2*)(lds + oXs + lrow * P64B + p0 * 2); const f32x4 a = accO[i]; u32x2 wv;
                wv.x = pk2((a[0] + c_Dh * bflo(xs.x)) * silu(bflo(z.x)), (a[1] + c_Dh * bfhi(xs.x)) * silu(bfhi(z.x)));
                wv.y = pk2((a[2] + c_Dh * bflo(xs.y)) * silu(bflo(z.y)), (a[3] + c_Dh * bfhi(xs.y)) * silu(bfhi(z.y))); *(u32x2*)zp = wv; }
        } else {
            float ss = 0.f;
#pragma unroll
            for (int i = 0; i < NVW; ++i) ss += (accO[i][0] * accO[i][0] + accO[i][1] * accO[i][1]) + (accO[i][2] * accO[i][2] + accO[i][3] * accO[i][3]);
            ss += __shfl_xor(ss, 16); ss += __shfl_xor(ss, 32);
            if (q4 == 0) red[lrow * 2 + wh] = ss;
        }
        }
#pragma unroll
        for (int i = 0; i < NT; ++i) { const int d0 = 16 * dti + 4 * q4; f32x4 s = accS[i];
            if constexpr (KIND == 0) s = s * eglS; else { const f32x4 e = *(const LAS f32x4*)(egl + d0); s = s * e; }
#pragma unroll
            for (int ks = 0; ks < 2; ++ks) { const int kb0 = ks * 64 + q4 * 16; s = MFMA16(FRAG(oKh, 16 * dti + r16, P64B), FRAG(oVt, 16 * (vt0 + i) + r16, P64B), s); }
            accS[i] = s; }
        BAR_LDS();
        if constexpr (KIND != 0 && MODE == 1) {
            const float rstd = 1.0f / sqrtf((red[lrow * 2] + red[lrow * 2 + 1]) * (1.f / 128.f) + EPS_);
            const float* nw = (KIND == 1 ? P.in[30] : P.in[33]) + h * 128; const int gofs = (KIND == 1 ? 0 : 512) + h * 128;
#pragma unroll
            for (int i = 0; i < NVW; ++i) { const int v0 = 16 * (wh * NVW + i) + 4 * q4; bf16_t* gp = BIG + (size_t)(t0 + lrow) * LD + gofs + v0;
                const u32x2 gt = *(const u32x2*)gp; const f32x4 nv = *(const f32x4*)(nw + v0); const f32x4 a = accO[i] * rstd * nv; u32x2 wv;
                wv.x = pk2(a[0] * silu(bflo(gt.x)), a[1] * silu(bfhi(gt.x))); wv.y = pk2(a[2] * silu(bflo(gt.y)), a[3] * silu(bfhi(gt.y))); *(u32x2*)gp = wv; }
        }
    }
    if constexpr (MODE == 0) {
        float* rec = stbase + (size_t)seg * REC;
#pragma unroll
        for (int i = 0; i < NT; ++i) *(f32x4*)(rec + ((size_t)(w * NT + i) * 64 + lane) * 4) = accS[i];
        if constexpr (KIND == 0) { if (tid == 0) rec[DK * DV] = gsum; }
        else { if (tid < DK) rec[DK * DV + tid] = gsum; }
    }
}
template <int MODE>
DI void s5_wave(const Params& P, LAS unsigned char* wl  , const int b, const int g, const int seg, float* hst  ) {
    const int lane = otid() & 63, r16 = lane & 15, q4 = lane >> 4;
    LAS float* bu = (LAS float*)wl;
    LAS bf16_t* hb = (LAS bf16_t*)(wl + 16 * 132 * 4);
    const float* ltab = (const float*)(P.ws + OFF_S5L) + (size_t)(g * 64 + lane) * 2; const float lbr = ltab[0], lbi = ltab[1];
    const float* btab = (const float*)(P.ws + OFF_S5B) + (size_t)g * 128 * 16;
    bf16x8 bfr[8];
#pragma unroll
    for (int j = 0; j < 8; ++j) { u32x4 wv = {0u, 0u, 0u, 0u};
        if (q4 < 2) { const float* s = btab + (16 * j + r16) * 16 + 8 * q4; wv.x = pk2(s[0], s[1]); wv.y = pk2(s[2], s[3]); wv.z = pk2(s[4], s[5]); wv.w = pk2(s[6], s[7]); }
        bfr[j] = __builtin_bit_cast(bf16x8, wv); }
    bf16x8 cfr[4];
#pragma unroll
    for (int ks = 0; ks < 4; ++ks) { const int n0 = 32 * ks + 8 * q4; float v[8];
#pragma unroll
        for (int i = 0; i < 8; ++i) { const int n = n0 + i; v[i] = n < 64 ? P.in[22][(size_t)(g * 16 + r16) * 64 + n] : -P.in[23][(size_t)(g * 16 + r16) * 64 + n - 64]; }
        u32x4 wv; wv.x = pk2(v[0], v[1]); wv.y = pk2(v[2], v[3]); wv.z = pk2(v[4], v[5]); wv.w = pk2(v[6], v[7]); cfr[ks] = __builtin_bit_cast(bf16x8, wv); }
    float dsk[4];
#pragma unroll
    for (int j = 0; j < 4; ++j) dsk[j] = P.in[24][g * 16 + 4 * q4 + j];
    bf16_t* U = (bf16_t*)(P.ws + OFF_BIG) + (size_t)b * L_ * ABW + 3072 + g * 16;
    float hr = 0.f, hi = 0.f;
    if constexpr (MODE == 1) { float pr = lbr, pi = lbi;
#pragma unroll
        for (int k = 0; k < 9; ++k) { const float nr = pr * pr - pi * pi, ni = 2.f * pr * pi; pr = nr; pi = ni; }
        for (int j = 0; j < seg; ++j) { const float ar = hst[(j * 64 + lane) * 2], ai = hst[(j * 64 + lane) * 2 + 1]; const float nr = pr * hr - pi * hi + ar, ni = pr * hi + pi * hr + ai; hr = nr; hi = ni; } }
    const int c0 = seg * 8;
    u32x4 an[4]; u32x2 un[4];
#pragma unroll
    for (int s = 0; s < 4; ++s) { an[s] = (u32x4){0u, 0u, 0u, 0u}; if (q4 < 2) an[s] = *(const u32x4*)(U + (size_t)(c0 * 64 + s * 16 + r16) * ABW + 8 * q4); un[s] = *(const u32x2*)(U + (size_t)(c0 * 64 + s * 16 + r16) * ABW + 4 * q4); }
    for (int c = c0; c < c0 + 8; ++c) {
        u32x4 ac[4]; u32x2 uc[4];
#pragma unroll
        for (int s = 0; s < 4; ++s) { ac[s] = an[s]; uc[s] = un[s]; }
        if (c < c0 + 7) {
#pragma unroll
            for (int s = 0; s < 4; ++s) { const bf16_t* up = U + (size_t)((c + 1) * 64 + s * 16 + r16) * ABW; if (q4 < 2) an[s] = *(const u32x4*)(up + 8 * q4); un[s] = *(const u32x2*)(up + 4 * q4); }
        }
#pragma unroll
        for (int s = 0; s < 4; ++s) {
            const bf16x8 af = __builtin_bit_cast(bf16x8, ac[s]);
#pragma unroll
            for (int j = 0; j < 8; ++j) { f32x4 a = {0.f, 0.f, 0.f, 0.f}; a = MFMA16(af, bfr[j], a);
#pragma unroll
                for (int jj = 0; jj < 4; ++jj) bu[(4 * q4 + jj) * 132 + 16 * j + r16] = a[jj]; }
            __builtin_amdgcn_fence(__ATOMIC_RELEASE, "wavefront"); __builtin_amdgcn_wave_barrier(); __builtin_amdgcn_fence(__ATOMIC_ACQUIRE, "wavefront");
#pragma unroll
            for (int t = 0; t < 16; ++t) { const float re = bu[t * 132 + lane], im = bu[t * 132 + 64 + lane];
                const float nr = lbr * hr - lbi * hi + re, ni = lbr * hi + lbi * hr + im; hr = nr; hi = ni;
                if constexpr (MODE == 1) { hb[t * 136 + lane] = f2bf(hr); hb[t * 136 + 64 + lane] = f2bf(hi); } }
            __builtin_amdgcn_fence(__ATOMIC_RELEASE, "wavefront"); __builtin_amdgcn_wave_barrier(); __builtin_amdgcn_fence(__ATOMIC_ACQUIRE, "wavefront");
            if constexpr (MODE == 1) {
            f32x4 y = {0.f, 0.f, 0.f, 0.f};
#pragma unroll
            for (int ks = 0; ks < 4; ++ks) { const bf16x8 hf = *(const LAS bf16x8*)(hb + r16 * 136 + 32 * ks + 8 * q4); y = MFMA16(cfr[ks], hf, y); }
            const float u0 = bflo(uc[s].x), u1 = bfhi(uc[s].x), u2 = bflo(uc[s].y), u3 = bfhi(uc[s].y); u32x2 wv;
            wv.x = pk2(gelu_t(y[0] + dsk[0] * u0), gelu_t(y[1] + dsk[1] * u1)); wv.y = pk2(gelu_t(y[2] + dsk[2] * u2), gelu_t(y[3] + dsk[3] * u3));
            *(u32x2*)(U + (size_t)(c * 64 + s * 16 + r16) * ABW + 4 * q4) = wv;
            }
            __builtin_amdgcn_wave_barrier();
        }
    }
    if constexpr (MODE == 0) { hst[(seg * 64 + lane) * 2] = hr; hst[(seg * 64 + lane) * 2 + 1] = hi; }
}
constexpr size_t OFF_XB2 = OFF_PB + (size_t)T_ * 256 * 2;
static_assert(OFF_XB2 + (size_t)T_ * 1024 * 2 <= OFF_BIG + SZ_BIG, "BIG tail");
constexpr size_t OFF_BAR = (WS_END + 255) & ~(size_t)255;
constexpr size_t WS_TOTAL = OFF_BAR + XCD_BAR_WORDS * 4;
__global__ void __launch_bounds__(512, 2) mega(Params P) {
    extern __shared__ __attribute__((aligned(16))) unsigned char shm[];
    LAS unsigned char* lds = (LAS unsigned char*)shm;
    cg::grid_group grid = cg::this_grid();
    unsigned char* ws = P.ws;
    bf16_t* XB = (bf16_t*)(ws + OFF_XB); bf16_t* XB2 = (bf16_t*)(ws + OFF_XB2); bf16_t* BIG = (bf16_t*)(ws + OFF_BIG); bf16_t* PB = (bf16_t*)(ws + OFF_PB); float* PP = (float*)(ws + OFF_BIG); float* X = P.out;
    const int wave = __builtin_amdgcn_readfirstlane(otid() >> 6);
    unsigned* barw = (unsigned*)(ws + OFF_BAR); volatile LAS unsigned* bst = (volatile LAS unsigned*)(lds + LDS_BYTES - 16);
    if (otid() < 2) bst[otid()] = 0u;
    if (blockIdx.x == 0) for (int i = otid(); i < XCD_BAR_WORDS; i += 512) barw[i] = 0u;
    __syncthreads();
    p0_phase(P, lds);
    grid.sync();
    const XcdBarrier xb = xcd_barrier_post(barw, bst);
#define GSYNC() xcd_barrier(xb)
#ifdef PROBE_SYNC
    for (int k = 0; k < 20; ++k) GSYNC();
#endif
#ifdef PROBE_P0
    p0_phase(P, lds); GSYNC();
#endif
#pragma unroll 1
    for (int l = 0; l < 2; ++l) {
        const float* lng = P.in[2] + (size_t)l * 3 * D_; const float* lnb = P.in[3] + (size_t)l * 3 * D_;
        run_gemm(lds, l == 0 ? XB : XB2, D_, (const bf16_t*)(ws + OFF_WGU + (size_t)(l * 2) * SZ_WGU), 5632, D_, EpiSwiGLU{BIG}); GSYNC();
#ifdef PROBE_GU
        run_gemm(lds, l == 0 ? XB : XB2, D_, (const bf16_t*)(ws + OFF_WGU + (size_t)(l * 2) * SZ_WGU), 5632, D_, EpiSwiGLU{BIG}); GSYNC();
#endif
        run_gemm(lds, BIG, FF_, (const bf16_t*)(ws + OFF_WD + (size_t)(l * 2) * SZ_WD), D_, FF_, EpiRes{l == 0 ? P.in[0] : X, X, 0.5f}); GSYNC();
        ln_phase(X, XB, lng, lnb); GSYNC();
        if (l == 0) {
            run_gemm(lds, XB, D_, (const bf16_t*)(ws + OFF_WABIN), ABW, D_, EpiBf16{BIG, ABW}); GSYNC();
            {
                float* stb = (float*)(ws + OFF_XB); float* s5b = stb + (size_t)64 * 4 * (128 * 64 + 128);
                for (int it = blockIdx.x; it < 256; it += gridDim.x) {
                    { const int bb = it >> 6, hh = (it >> 2) & 15, sg = it & 3; if (sg < 3) cla_item<0, 0, 4>(P, lds, bb, hh, sg, stb + (size_t)((bb * 16 + hh) * 4) * (128 * 64 + 128)); }
                    __syncthreads();
                    { const int bb = it >> 6, gg = it & 63; if (wave < 7) s5_wave<0>(P, lds + wave * 13312, bb, gg, wave, s5b + (size_t)((bb * 64 + gg) * 8) * 128); }
                    __syncthreads();
                }
                GSYNC();
                for (int it = blockIdx.x; it < 256; it += gridDim.x) {
                    { const int bb = it >> 6, hh = (it >> 2) & 15, sg = it & 3; cla_item<0, 1, 4>(P, lds, bb, hh, sg, stb + (size_t)((bb * 16 + hh) * 4) * (128 * 64 + 128)); }
                    __syncthreads();
                    { const int bb = it >> 6, gg = it & 63; s5_wave<1>(P, lds + wave * 13312, bb, gg, wave, s5b + (size_t)((bb * 64 + gg) * 8) * 128); }
                    __syncthreads();
                }
            }
            GSYNC();
            run_gemm(lds, BIG + 3072, ABW, (const bf16_t*)(ws + OFF_WGLU), D_, D_, EpiGLU{BIG + 3072, BIG + 1024, P.in[26]});
            ssd_rms_phase(BIG, P.in[16]); GSYNC();
            run_gemm(lds, BIG, ABW, (const bf16_t*)(ws + OFF_WABOUT), D_, 2048, EpiRes{X, X, 1.0f}); GSYNC();
        } else {
            run_gemm(lds, XB, D_, (const bf16_t*)(ws + OFF_WCDIN), CDW, D_, EpiBf16{BIG, CDW}); GSYNC();
            {
                float* stb1 = (float*)(ws + OFF_XB); float* stb2 = stb1 + (size_t)16 * 8 * (128 * 128 + 128);
                for (int it = blockIdx.x; it < 256; it += gridDim.x) { const int rem = it & 127, bb = rem >> 5, hh = (rem >> 3) & 3, sg = rem & 7;
                    if (sg < 7) { if (it < 128) cla_item<1, 0, 8>(P, lds, bb, hh, sg, stb1 + (size_t)((bb * 4 + hh) * 8) * (128 * 128 + 128));
                                  else cla_item<2, 0, 8>(P, lds, bb, hh, sg, stb2 + (size_t)((bb * 4 + hh) * 8) * (64 * 128 + 128)); }
                    __syncthreads(); }
                GSYNC();
                for (int it = blockIdx.x; it < 256; it += gridDim.x) { const int rem = it & 127, bb = rem >> 5, hh = (rem >> 3) & 3, sg = rem & 7;
                    if (it < 128) cla_item<1, 1, 8>(P, lds, bb, hh, sg, stb1 + (size_t)((bb * 4 + hh) * 8) * (128 * 128 + 128));
                    else cla_item<2, 1, 8>(P, lds, bb, hh, sg, stb2 + (size_t)((bb * 4 + hh) * 8) * (64 * 128 + 128));
                    __syncthreads(); }
            }
            GSYNC();
            run_gemm(lds, BIG, CDW, (const bf16_t*)(ws + OFF_WCDOUT), D_, D_, EpiRes{X, X, 1.0f}); GSYNC();
        }
        ln_phase(X, XB, lng + D_, lnb + D_); GSYNC();
        run_gemm(lds, XB, D_, (const bf16_t*)(ws + OFF_WGU + (size_t)(l * 2 + 1) * SZ_WGU), 5632, D_, EpiSwiGLU{BIG}); GSYNC();
        run_gemm(lds, BIG, FF_, (const bf16_t*)(ws + OFF_WD + (size_t)(l * 2 + 1) * SZ_WD), D_, FF_, EpiRes{X, X, 0.5f}); GSYNC();
        ln_phase(X, XB, lng + 2 * D_, lnb + 2 * D_); p_to_bf16(P.in[1] + (size_t)l * T_ * 256, PB); GSYNC();
        run_gemm(lds, PB, 256, (const bf16_t*)(ws + OFF_WPP + (size_t)l * SZ_WPP), D_, 256, EpiF32{PP});
        run_gemm(lds, XB, D_, (const bf16_t*)(ws + OFF_WPG + (size_t)l * SZ_W1K), D_, D_, EpiPLE{X, PP, XB2});
        if (l == 0) GSYNC();
    }
}

extern "C" void kernel_launch(void* const* d_in, const int* in_sizes, int n_in, void* d_out, int out_size, void* d_ws, size_t ws_size, hipStream_t stream) {
    static int grid = 0;
    if (grid == 0) {
        if (n_in != 34 || out_size != T_ * D_ || ws_size < WS_TOTAL) { fprintf(stderr, "kernel_launch: unexpected shapes (n_in %d, out %d, ws %zu < %zu)\n", n_in, out_size, ws_size, (size_t)WS_TOTAL); grid = -1; return; }
        int dev = 0, cus = 0, per_cu = 0;
        hipGetDevice(&dev); hipDeviceGetAttribute(&cus, hipDeviceAttributeMultiprocessorCount, dev);
        if (hipFuncSetAttribute((const void*)mega, hipFuncAttributeMaxDynamicSharedMemorySize, LDS_BYTES) != hipSuccess) { fprintf(stderr, "kernel_launch: hipFuncSetAttribute failed\n"); grid = -1; return; }
        if (hipOccupancyMaxActiveBlocksPerMultiprocessor(&per_cu, (const void*)mega, 512, LDS_BYTES) != hipSuccess || per_cu < 1) { fprintf(stderr, "kernel_launch: occupancy query says %d\n", per_cu); per_cu = 1; }
        (void)hipGetLastError();
        grid = cus * per_cu;
    }
    if (grid < 0) return;
    Params P{};
    for (int i = 0; i < 34; ++i) P.in[i] = (const float*)d_in[i];
    P.out = (float*)d_out; P.ws = (unsigned char*)d_ws;
    void* args[] = {&P};
    hipError_t e = hipLaunchCooperativeKernel((const void*)mega, dim3(grid), dim3(512), args, LDS_BYTES, stream);
    if (e != hipSuccess) fprintf(stderr, "cooperative launch failed: %s (grid %d)\n", hipGetErrorString(e), grid);
}
```
